# Optimizing an MI355X kernel written in HIP

```python
import jax, jax.numpy as jnp
from jax import lax
import numpy as np

D_MODEL = 1024
BATCH = 32
SEQ = 2048
DEPTH = 2

CHUNK = 128
D_MIX = D_MODEL
GA_GROUPS = 4
GA_WIDTH = D_MIX // 4
GA_HEAD = GA_WIDTH // GA_GROUPS
MB_HEADS = 4
MB_WIDTH = 3 * D_MIX // 8
MB_HEAD = MB_WIDTH // MB_HEADS
MB_CONV = 4
SC_HEADS = 6
SC_WIDTH = D_MIX - GA_WIDTH - MB_WIDTH
SC_HEAD = SC_WIDTH // SC_HEADS
EPS = 1e-6
IN_SPLITS = (GA_WIDTH,) * 3 + (MB_WIDTH,) * 5 + (MB_HEADS,) * 2 + (SC_WIDTH,) * 4
D_IN = sum(IN_SPLITS)

kernel_name = "hybrid_gmlp_mlstm_stickbreaking_block"


def rms_norm(x, g):
    xf = x.astype(jnp.float32)
    y = xf * lax.rsqrt(jnp.mean(xf * xf, axis=-1, keepdims=True) + EPS)
    return (y * g.astype(jnp.float32)).astype(x.dtype)


def causal_conv(x, w, b):
    K, S = w.shape[0], x.shape[1]
    xp = jnp.pad(x, ((0, 0), (K - 1, 0), (0, 0)))
    y = b
    for tap in range(K):
        y = y + xp[:, tap:tap + S] * w[tap]
    return y


def spatial_gating_branch(u, v, v_norm_g, w_s, b_s):
    B, S, _ = u.shape
    nc = S // CHUNK
    u = jax.nn.gelu(u)
    v = rms_norm(jax.nn.gelu(v).reshape(B, nc, CHUNK, GA_GROUPS, GA_HEAD), v_norm_g)
    causal = jnp.tril(jnp.ones((CHUNK, CHUNK), dtype=bool))
    w = jnp.where(causal, w_s, 0).astype(v.dtype)
    sp = jnp.einsum('gts,bcsgd->bctgd', w, v) + b_s.T[:, :, None].astype(v.dtype)
    return u * sp.reshape(B, S, GA_WIDTH)


def mlstm_branch(q, k, v, i_raw, f_raw):
    out_dtype = v.dtype
    q, k, v = (a.astype(jnp.float32) for a in (q, k, v))
    B, S, H, d = q.shape
    nc = S // CHUNK
    k = k * (d ** -0.5)
    i_log = i_raw.astype(jnp.float32)
    f_log = jax.nn.log_sigmoid(f_raw.astype(jnp.float32))

    def to_chunks(a):
        a = a.reshape((B, nc, CHUNK, H) + a.shape[3:])
        return jnp.moveaxis(a, (1, 3), (0, 2))

    xs = (to_chunks(q), to_chunks(k), to_chunks(v), to_chunks(i_log), to_chunks(f_log))
    causal = jnp.tril(jnp.ones((CHUNK, CHUNK), dtype=bool))

    def step(carry, inp):
        C, n, m = carry
        qb, kb, vb, ib, lfb = inp
        bcum = jnp.cumsum(lfb, axis=-1)
        d_log = jnp.where(causal, bcum[..., :, None] - bcum[..., None, :] + ib[..., None, :], -jnp.inf)
        inter = bcum + m[..., None]
        m_t = jnp.maximum(inter, jnp.max(d_log, axis=-1))
        w_intra = jnp.exp(d_log - m_t[..., None])
        w_inter = jnp.exp(inter - m_t)
        s = jnp.einsum('bhtd,bhsd->bhts', qb, kb) * w_intra
        num = jnp.einsum('bhts,bhsd->bhtd', s, vb) + w_inter[..., None] * jnp.einsum('bhed,bhtd->bhte', C, qb)
        den = jnp.sum(s, axis=-1) + w_inter * jnp.einsum('bhd,bhtd->bht', n, qb)
        h = num / jnp.maximum(jnp.abs(den), jnp.exp(-m_t))[..., None]
        b_tot = bcum[..., -1]
        log_ws = b_tot[..., None] - bcum + ib
        m_new = jnp.maximum(b_tot + m, jnp.max(log_ws, axis=-1))
        decay = jnp.exp(b_tot + m - m_new)
        ws = jnp.exp(log_ws - m_new[..., None])
        C = decay[..., None, None] * C + jnp.einsum('bhs,bhse,bhsd->bhed', ws, vb, kb)
        n = decay[..., None] * n + jnp.einsum('bhs,bhsd->bhd', ws, kb)
        return (C, n, m_new), h

    init = (jnp.zeros((B, H, d, d), jnp.float32), jnp.zeros((B, H, d), jnp.float32),
            jnp.zeros((B, H), jnp.float32))
    _, hs = lax.scan(step, init, xs)
    h = jnp.moveaxis(hs, (0, 2), (1, 3)).reshape(B, S, H, d)
    return h.astype(out_dtype)


def stick_breaking_branch(q, k, v):
    B, S, H, d = q.shape
    scale = d ** -0.5
    outs = []
    for blk in range(S // CHUNK):
        t0 = blk * CHUNK
        kv_len = t0 + CHUNK
        qb, kb, vb = q[:, t0:kv_len], k[:, :kv_len], v[:, :kv_len]
        z = jnp.einsum('bthd,bshd->bhts', qb, kb).astype(jnp.float32) * scale
        t_idx = t0 + jnp.arange(CHUNK)
        s_idx = jnp.arange(kv_len)
        strict = s_idx[None, :] < t_idx[:, None]
        log_not = jnp.where(strict, jax.nn.log_sigmoid(-z), 0.0)
        suffix = lax.cumsum(log_not, axis=3, reverse=True) - log_not
        a = jnp.where(strict, jnp.exp(jax.nn.log_sigmoid(z) + suffix), 0.0)
        outs.append(jnp.einsum('bhts,bshd->bthd', a.astype(vb.dtype), vb))
    return jnp.concatenate(outs, axis=1)


def hybrid_layer(x, c_act, norm_g, w_ada, b_ada, w_in, ga_v_norm, ga_ws, ga_bs,
                 mb_conv_w, mb_conv_b, mb_b_i, mb_b_f, mb_h_norm, sc_q_norm, sc_k_norm, w_out):
    B, S, _ = x.shape
    shift, scale, gate = jnp.split(c_act @ w_ada + b_ada, 3, axis=-1)
    h = rms_norm(x, norm_g) * (1 + scale[:, None]) + shift[:, None]
    proj = h @ w_in
    offsets = [int(o) for o in np.cumsum(IN_SPLITS)[:-1]]
    (ga_u, ga_v, ga_z, mb_q, mb_k, mb_v, mb_o, mb_z, mb_i, mb_f,
     sc_q, sc_k, sc_v, sc_z) = jnp.split(proj, offsets, axis=-1)

    y_a = spatial_gating_branch(ga_u, ga_v, ga_v_norm, ga_ws, ga_bs) * jax.nn.silu(ga_z)

    qk = jax.nn.silu(causal_conv(jnp.concatenate([mb_q, mb_k], axis=-1), mb_conv_w, mb_conv_b))
    q_b, k_b = jnp.split(qk, 2, axis=-1)
    heads_b = lambda a: a.reshape(B, S, MB_HEADS, MB_HEAD)
    h_b = mlstm_branch(heads_b(q_b), heads_b(k_b), heads_b(mb_v), mb_i + mb_b_i, mb_f + mb_b_f)
    h_b = rms_norm(h_b, mb_h_norm).reshape(B, S, MB_WIDTH)
    y_b = jax.nn.sigmoid(mb_o) * h_b * jax.nn.silu(mb_z)

    heads_c = lambda a: a.reshape(B, S, SC_HEADS, SC_HEAD)
    h_c = stick_breaking_branch(rms_norm(heads_c(sc_q), sc_q_norm), rms_norm(heads_c(sc_k), sc_k_norm),
                                heads_c(sc_v))
    y_c = h_c.reshape(B, S, SC_WIDTH) * jax.nn.silu(sc_z)

    y = jnp.concatenate([y_a, y_b, y_c], axis=-1) @ w_out
    return x + gate[:, None] * y


def setup_inputs(seed: int = 0) -> dict:
    key = jax.random.key(seed)
    ks = jax.random.split(key, 17)
    nrm = lambda k, shape: jax.random.normal(k, shape, jnp.float32)
    D = D_MODEL
    return {
        "x": nrm(ks[0], (BATCH, SEQ, D)),
        "c": nrm(ks[1], (BATCH, D)),
        "norm_g": 1.0 + 0.02 * nrm(ks[2], (DEPTH, D)),
        "w_ada": nrm(ks[3], (DEPTH, D, 3 * D)) * (0.5 * D ** -0.5),
        "b_ada": 0.01 * nrm(ks[4], (DEPTH, 3 * D)),
        "w_in": nrm(ks[5], (DEPTH, D, D_IN)) * D ** -0.5,
        "ga_v_norm": 1.0 + 0.02 * nrm(ks[6], (DEPTH, GA_GROUPS, GA_HEAD)),
        "ga_ws": nrm(ks[7], (DEPTH, GA_GROUPS, CHUNK, CHUNK)) * CHUNK ** -0.5,
        "ga_bs": 1.0 + 0.02 * nrm(ks[8], (DEPTH, GA_GROUPS, CHUNK)),
        "mb_conv_w": nrm(ks[9], (DEPTH, MB_CONV, 2 * MB_WIDTH)) * MB_CONV ** -0.5,
        "mb_conv_b": 0.01 * nrm(ks[10], (DEPTH, 2 * MB_WIDTH)),
        "mb_b_i": 0.1 * nrm(ks[11], (DEPTH, MB_HEADS)),
        "mb_b_f": jnp.linspace(3.0, 6.0, MB_HEADS, dtype=jnp.float32)[None, :] + 0.01 * nrm(ks[12], (DEPTH, MB_HEADS)),
        "mb_h_norm": 1.0 + 0.02 * nrm(ks[13], (DEPTH, MB_HEADS, MB_HEAD)),
        "sc_q_norm": 1.0 + 0.02 * nrm(ks[14], (DEPTH, SC_HEAD)),
        "sc_k_norm": 1.0 + 0.02 * nrm(ks[15], (DEPTH, SC_HEAD)),
        "w_out": nrm(ks[16], (DEPTH, D_MIX, D)) * D_MIX ** -0.5,
    }


def reference(x, c, norm_g, w_ada, b_ada, w_in, ga_v_norm, ga_ws, ga_bs, mb_conv_w, mb_conv_b,
              mb_b_i, mb_b_f, mb_h_norm, sc_q_norm, sc_k_norm, w_out):
    c_act = jax.nn.silu(c)
    for l in range(DEPTH):
        x = hybrid_layer(x, c_act, norm_g[l], w_ada[l], b_ada[l], w_in[l], ga_v_norm[l], ga_ws[l],
                         ga_bs[l], mb_conv_w[l], mb_conv_b[l], mb_b_i[l], mb_b_f[l], mb_h_norm[l],
                         sc_q_norm[l], sc_k_norm[l], w_out[l])
    return x
```

```cpp
#include <hip/hip_runtime.h>
#include <hip/hip_cooperative_groups.h>
#include <cstdio>
#include <cstdint>
namespace cg = cooperative_groups;
#ifndef ONE_LAUNCH
#define ONE_LAUNCH 1
#endif
namespace pg8 {
#define PG8_LAS __attribute__((address_space(3)))
typedef unsigned short bf16_t;
typedef short bf16x8 __attribute__((ext_vector_type(8)));
typedef float f32x4 __attribute__((ext_vector_type(4)));
typedef unsigned u32x4 __attribute__((ext_vector_type(4)));
constexpr int BM = 256, BK = 64, HALF = 128, HTB = HALF * BK * 2  , STAGE_BYTES = 8 * HTB, NXCD = 8, WGM = 8;

__host__ __device__ __forceinline__ int lds_byte(int r, int c) { const int st = (r >> 4) * 2 + (c >> 5), rr = r & 15, cc = c & 31, ob = rr * 64 + cc * 2; return st * 1024 + (ob ^ (((ob >> 9) & 1) << 5)); }
__host__ __device__ __forceinline__ void stage_rc(int b, int& R, int& C) { const int st = b / 1024, sb = b % 1024, swz = sb ^ (((sb >> 9) & 1) << 5); R = (st >> 1) * 16 + swz / 64; C = (st & 1) * 32 + (swz % 64) / 2; }
__host__ __device__ __forceinline__ int perm32(int rho) { const int n = rho >> 4, i = rho & 15; return 8 * (i >> 2) + 4 * n + (i & 3); }

struct Unit { int pm, pn; };
struct Gemm { const bf16_t* A; const bf16_t* Bt; int M, N, K; };

struct StaticOrder {
    int nM, nN, nwg, G, c;
    __host__ __device__ void init(int M, int N, int G_, int c_) { nM = M / BM; nN = N / BM; nwg = nM * nN; G = G_; c = c_; }
    __host__ __device__ bool next(int i, Unit& u) const {
        const long L = (long)i * G + c; if (L >= nwg) return false;
        int wgid = (int)L; { const int q = nwg / NXCD, r = nwg % NXCD, xcd = wgid % NXCD, off = wgid / NXCD; wgid = (xcd < r ? xcd * (q + 1) : r * (q + 1) + (xcd - r) * q) + off; }
        const int nig = WGM * nN, gid = wgid / nig, fm = gid * WGM, gsz = (nM - fm) < WGM ? (nM - fm) : WGM;
        u.pm = fm + ((wgid % nig) % gsz); u.pn = (wgid % nig) / gsz; return true;
    }
    __device__ __forceinline__ void a_ready(const Unit&) const {}
    __device__ __forceinline__ void done(const Unit&) const {}
};

__device__ __forceinline__ unsigned cvt_pk_bf16(float lo, float hi) { unsigned r; asm volatile("v_cvt_pk_bf16_f32 %0, %1, %2" : "=v"(r) : "v"(lo), "v"(hi)); return r; }
template <class Epi, class Sched, bool ALIGN_EPI = false, bool SP2 = false>
__device__ __forceinline__ void gemm_phase(PG8_LAS unsigned char* lds, const Gemm g, const Sched& S, const Epi& E) {
    int tid_ = threadIdx.x; asm volatile("" : "+v"(tid_));
    const int tid = tid_, wid = __builtin_amdgcn_readfirstlane(tid >> 6), lane = tid & 63, wr = wid >> 2, wc = wid & 3, fr = lane & 15, fq = lane >> 4;
    const int K = g.K, nt = K / BK;
    unsigned voffA[2], voffB[2];
#pragma unroll
    for (int i = 0; i < 2; ++i) { int R, C; stage_rc(tid * 16 + i * 8192, R, C); const int Rb = Epi::PERM ? ((R & ~31) + perm32(R & 31)) : R;
        voffA[i] = (unsigned)(R * K + C) * 2u; voffB[i] = (unsigned)(Rb * K + C) * 2u; }
    const size_t kstep = (size_t)(BK * 2);
    const size_t hstep = (size_t)HALF * K * 2;
    const size_t tstep = 2 * hstep;
    const unsigned ldsw = (unsigned)wid * 1024u;
    const int aoff = lds_byte(wr * 64 + fr, fq * 8), boff = lds_byte(wc * 32 + fr, fq * 8);
#define PG8_SA(b, h) (((b) * 2 + (h)) * HTB)
#define PG8_SB(b, h) ((4 + (b) * 2 + (h)) * HTB)
#define PG8_STAGE(bufoff, gbase, voff) do { _Pragma("unroll") for (int _i = 0; _i < 2; ++_i) \
        __builtin_amdgcn_global_load_lds((const unsigned*)((const char*)(gbase) + (voff)[_i]), (PG8_LAS unsigned*)(lds + (bufoff) + ldsw + _i * 8192), 16, 0, 0); } while (0)
#define PG8_LDA(dst, b, h) do { _Pragma("unroll") for (int m = 0; m < 4; ++m) _Pragma("unroll") for (int k = 0; k < 2; ++k) dst[m][k] = *(const PG8_LAS bf16x8*)(lds + PG8_SA(b, h) + aoff + m * 2048 + k * 1024); } while (0)
#define PG8_LDB(dst, b, h) do { _Pragma("unroll") for (int n = 0; n < 2; ++n) _Pragma("unroll") for (int k = 0; k < 2; ++k) dst[n][k] = *(const PG8_LAS bf16x8*)(lds + PG8_SB(b, h) + boff + n * 2048 + k * 1024); } while (0)
#define PG8_MMA(ai, bj, At, Bt) do { __builtin_amdgcn_s_setprio(1); _Pragma("unroll") for (int m = 0; m < 4; ++m) _Pragma("unroll") for (int n = 0; n < 2; ++n) _Pragma("unroll") for (int k = 0; k < 2; ++k) \
        acc[ai][bj][m][n] = __builtin_amdgcn_mfma_f32_16x16x32_bf16(Bt[n][k], At[m][k], acc[ai][bj][m][n], 0, 0, 0); __builtin_amdgcn_s_setprio(0); } while (0)
#define PG8_WAIT_V(n) asm volatile("s_waitcnt vmcnt(" #n ")" ::: "memory")
#define PG8_WAIT_L(n) asm volatile("s_waitcnt lgkmcnt(" #n ")" ::: "memory")
#define PG8_BAR __builtin_amdgcn_s_barrier()
#define PG8_SCHED __builtin_amdgcn_sched_barrier(0)
    Unit cur, nxt; int ui = 0;
    if (!S.next(0, cur)) return;
    f32x4 acc[2][2][4][2];
#pragma unroll
    for (int a = 0; a < 2; ++a)
#pragma unroll
        for (int b = 0; b < 2; ++b)
#pragma unroll
            for (int m = 0; m < 4; ++m)
#pragma unroll
                for (int n = 0; n < 2; ++n) acc[a][b][m][n] = (f32x4){0.f, 0.f, 0.f, 0.f};
    bf16x8 At[4][2], B0[2][2], B1[2][2];
    const char* cA = (const char*)g.A + (size_t)cur.pm * tstep; const char* cB = (const char*)g.Bt + (size_t)cur.pn * tstep;
    S.a_ready(cur);
    if constexpr (SP2) {
        PG8_STAGE(PG8_SB(0, 0), cB, voffB); PG8_STAGE(PG8_SB(0, 1), cB + hstep, voffB); PG8_STAGE(PG8_SA(0, 0), cA, voffA); PG8_STAGE(PG8_SA(0, 1), cA + hstep, voffA);
        if (wr == 1) PG8_BAR;
        PG8_WAIT_V(2); PG8_BAR;
        PG8_STAGE(PG8_SB(1, 0), cB + kstep, voffB); PG8_STAGE(PG8_SA(1, 0), cA + kstep, voffA); PG8_STAGE(PG8_SB(1, 1), cB + hstep + kstep, voffB);
        PG8_WAIT_V(6); PG8_BAR;
    } else {
        PG8_STAGE(PG8_SB(0, 0), cB, voffB); PG8_STAGE(PG8_SA(0, 0), cA, voffA); PG8_STAGE(PG8_SB(0, 1), cB + hstep, voffB); PG8_STAGE(PG8_SA(0, 1), cA + hstep, voffA);
        if (wr == 1) PG8_BAR;
        PG8_WAIT_V(4); PG8_BAR;
        PG8_STAGE(PG8_SB(1, 0), cB + kstep, voffB); PG8_STAGE(PG8_SA(1, 0), cA + kstep, voffA); PG8_STAGE(PG8_SB(1, 1), cB + hstep + kstep, voffB);
        PG8_WAIT_V(6); PG8_BAR;
    }
    for (;;) {
        const bool has_next = S.next(ui + 1, nxt);
        const char* nA = has_next ? (const char*)g.A + (size_t)nxt.pm * tstep : cA; const char* nB = has_next ? (const char*)g.Bt + (size_t)nxt.pn * tstep : cB;
        for (int t = 0; t < nt; t += 2) {
            const bool last = (t == nt - 2);
            const char* a1 = cA + (size_t)(t + 1) * kstep;
            const char* a2 = last ? nA : cA + (size_t)(t + 2) * kstep; const char* b2 = last ? nB : cB + (size_t)(t + 2) * kstep;
            const char* a3 = a2 + kstep; const char* b3 = b2 + kstep;
            if (last && has_next) S.a_ready(nxt);
            if constexpr (SP2) {
            PG8_LDB(B0, 0, 0); PG8_LDB(B1, 0, 1); PG8_SCHED; PG8_LDA(At, 0, 0); PG8_STAGE(PG8_SA(1, 1), a1 + hstep, voffA);
            PG8_WAIT_V(8); PG8_WAIT_L(0); PG8_BAR; PG8_MMA(0, 0, At, B0); PG8_MMA(0, 1, At, B1); PG8_BAR; PG8_SCHED;
            PG8_LDA(At, 0, 1); PG8_STAGE(PG8_SB(0, 0), b2, voffB); PG8_STAGE(PG8_SB(0, 1), b2 + hstep, voffB); PG8_STAGE(PG8_SA(0, 0), a2, voffA);
            PG8_WAIT_V(8); PG8_WAIT_L(0); PG8_BAR; PG8_MMA(1, 0, At, B0); PG8_MMA(1, 1, At, B1); PG8_BAR; PG8_SCHED;
            PG8_LDB(B0, 1, 0); PG8_LDB(B1, 1, 1); PG8_SCHED; PG8_LDA(At, 1, 0); PG8_STAGE(PG8_SA(0, 1), a2 + hstep, voffA);
            PG8_WAIT_V(8); PG8_WAIT_L(0); PG8_BAR; PG8_MMA(0, 0, At, B0); PG8_MMA(0, 1, At, B1); PG8_BAR; PG8_SCHED;
            PG8_LDA(At, 1, 1); PG8_STAGE(PG8_SB(1, 0), b3, voffB); PG8_STAGE(PG8_SB(1, 1), b3 + hstep, voffB); PG8_STAGE(PG8_SA(1, 0), a3, voffA);
            PG8_WAIT_V(8); PG8_WAIT_L(0); PG8_BAR; PG8_MMA(1, 0, At, B0); PG8_MMA(1, 1, At, B1); PG8_BAR; PG8_SCHED;
            } else {
            PG8_LDB(B0, 0, 0); PG8_SCHED; PG8_LDA(At, 0, 0); PG8_STAGE(PG8_SA(1, 1), a1 + hstep, voffA);
            PG8_WAIT_L(8); PG8_BAR; PG8_WAIT_L(0); PG8_MMA(0, 0, At, B0); PG8_BAR; PG8_SCHED;
            PG8_LDB(B1, 0, 1); PG8_STAGE(PG8_SB(0, 0), b2, voffB);
            PG8_BAR; PG8_WAIT_L(0); PG8_MMA(0, 1, At, B1); PG8_BAR;
            PG8_LDA(At, 0, 1); PG8_STAGE(PG8_SA(0, 0), a2, voffA);
            PG8_BAR; PG8_WAIT_L(0); PG8_MMA(1, 0, At, B0); PG8_BAR; PG8_SCHED;
            PG8_STAGE(PG8_SB(0, 1), b2 + hstep, voffB);
            PG8_WAIT_V(6); PG8_BAR; PG8_MMA(1, 1, At, B1); PG8_BAR;
            PG8_LDB(B0, 1, 0); PG8_SCHED; PG8_LDA(At, 1, 0); PG8_STAGE(PG8_SA(0, 1), a2 + hstep, voffA);
            PG8_WAIT_L(8); PG8_BAR; PG8_WAIT_L(0); PG8_MMA(0, 0, At, B0); PG8_BAR; PG8_SCHED;
            PG8_LDB(B1, 1, 1); PG8_STAGE(PG8_SB(1, 0), b3, voffB);
            PG8_BAR; PG8_WAIT_L(0); PG8_MMA(0, 1, At, B1); PG8_BAR;
            PG8_LDA(At, 1, 1); PG8_STAGE(PG8_SA(1, 0), a3, voffA);
            PG8_BAR; PG8_WAIT_L(0); PG8_MMA(1, 0, At, B0); PG8_BAR; PG8_SCHED;
            PG8_STAGE(PG8_SB(1, 1), b3 + hstep, voffB);
            PG8_WAIT_V(6); PG8_BAR; PG8_MMA(1, 1, At, B1); PG8_BAR;
            }
        }
        if constexpr (ALIGN_EPI) { if (wr == 0) PG8_BAR; }
        if constexpr (!Epi::AFTER_DRAIN) { E(acc, cur, wr, wc, fr, fq); S.done(cur); }
        if (!has_next) break;
#pragma unroll
        for (int a = 0; a < 2; ++a)
#pragma unroll
            for (int b = 0; b < 2; ++b)
#pragma unroll
                for (int m = 0; m < 4; ++m)
#pragma unroll
                    for (int n = 0; n < 2; ++n) acc[a][b][m][n] = (f32x4){0.f, 0.f, 0.f, 0.f};
        cur = nxt; cA = nA; cB = nB; ++ui;
        if constexpr (ALIGN_EPI) { if (wr == 1) PG8_BAR; }
    }
    PG8_WAIT_V(0);
    if constexpr (!ALIGN_EPI) { if (wr == 0) PG8_BAR; }
    PG8_BAR;
    if constexpr (Epi::AFTER_DRAIN) { E.fused(acc, cur, wr, wc, fr, fq, lds, wid, lane); S.done(cur); }
#undef PG8_SA
#undef PG8_SB
#undef PG8_STAGE
#undef PG8_LDA
#undef PG8_LDB
#undef PG8_MMA
#undef PG8_WAIT_V
#undef PG8_WAIT_L
#undef PG8_BAR
#undef PG8_SCHED
}
}

#define LAS __attribute__((address_space(3)))
typedef unsigned short bf16;
typedef unsigned v4u __attribute__((ext_vector_type(4)));
typedef unsigned v2u __attribute__((ext_vector_type(2)));
typedef float f32x4 __attribute__((ext_vector_type(4)));
typedef short bf16x8 __attribute__((ext_vector_type(8)));

constexpr int NB = 32, SEQ = 2048, DM = 1024, MTOK = NB * SEQ, DIN = 4232, NPJ = 4352;
constexpr int PU = 0, PV = 256, PZ = 512, PMQ = 768, PMK = 1152, PMV = 1536, PMO = 1920, PMZ = 2304, PSQ = 2688, PSK = 3072, PSV = 3456, PSZ = 3840, PGI = 4224;
constexpr float EPSN = 1e-6f, LOG2E = 1.4426950408889634f;
constexpr size_t MiB = 1u << 20;
constexpr size_t WS_CTL = 0, WS_MOD = 1 * MiB, WS_GATE = 2 * MiB, WS_WIN = 4 * MiB, WS_WOUT = 22 * MiB, WS_H = 32 * MiB, WS_PROJ = 160 * MiB, WS_HALO = 704 * MiB, WS_END = 712 * MiB;
constexpr size_t WIN_ELEMS = (size_t)NPJ * DM, WOUT_ELEMS = (size_t)DM * DM;
constexpr int LDS_BYTES = 147456;
constexpr int NPHASE = 9;
constexpr int N_ML = 128, N_AT = NB * 6 * 16, N_GM = NB * 4 * 4, N_UNITS = N_ML + N_AT + N_GM;

__device__ __forceinline__ unsigned pk2(float lo, float hi) { unsigned r; asm("v_cvt_pk_bf16_f32 %0, %1, %2" : "=v"(r) : "v"(lo), "v"(hi)); return r; }
__device__ __forceinline__ float blo(unsigned w) { return __uint_as_float(w << 16); }
__device__ __forceinline__ float bhi(unsigned w) { return __uint_as_float(w & 0xffff0000u); }
__device__ __forceinline__ float fexp2(float x) { return __builtin_amdgcn_exp2f(x); }
__device__ __forceinline__ float fexp(float x) { return __builtin_amdgcn_exp2f(x * LOG2E); }
__device__ __forceinline__ float frcp(float x) { return __builtin_amdgcn_rcpf(x); }
__device__ __forceinline__ float sigmoidf_(float x) { return frcp(1.0f + fexp2(-x * LOG2E)); }
__device__ __forceinline__ float siluf_(float x) { return x * sigmoidf_(x); }
__device__ __forceinline__ float geluf_(float x) { const float y = 1.5957691216057308f * (x + 0.044715f * x * x * x); return x * sigmoidf_(y); }
__device__ __forceinline__ float logsigf_(float x) { return fminf(x, 0.f) - 0.6931471805599453f * __builtin_amdgcn_logf(1.0f + fexp2(-fabsf(x) * LOG2E)); }
__device__ __forceinline__ f32x4 mfma16(bf16x8 a, bf16x8 b, f32x4 c) { return __builtin_amdgcn_mfma_f32_16x16x32_bf16(a, b, c, 0, 0, 0); }
__device__ __forceinline__ bf16x8 mk8(unsigned a, unsigned b, unsigned c, unsigned d) { v4u w; w.x = a; w.y = b; w.z = c; w.w = d; return __builtin_bit_cast(bf16x8, w); }
#define LBAR() do { asm volatile("s_waitcnt lgkmcnt(0)" ::: "memory"); __builtin_amdgcn_s_barrier(); asm volatile("" ::: "memory"); } while (0)
__device__ __forceinline__ float wave_sum(float v) {
#pragma unroll
    for (int o = 1; o < 64; o <<= 1) v += __shfl_xor(v, o);
    return v;
}

__device__ __forceinline__ float actf(float x, int act) {
    const float y = act == 1 ? 1.5957691216057308f * (x + 0.044715f * x * x * x) : x;
    const float sg = sigmoidf_(y);
    return act == 3 ? sg : x * sg;
}
template <int K> __device__ __forceinline__ float row_prev(float xm, float xm1) {
    const int o = __builtin_amdgcn_update_dpp(0, __float_as_int(xm1), 0x120 + K, 0xf, 0xf, false);
    return __int_as_float(__builtin_amdgcn_update_dpp(o, __float_as_int(xm), 0x110 + K, 0xf, 0xf, false));
}
struct EpiProj {
    static constexpr bool PERM = true, AFTER_DRAIN = false;
    bf16* O; float* gate; const float* convw; const float* convb; bf16* halo;
    __device__ __forceinline__ void operator()(const f32x4 (&acc)[2][2][4][2], const pg8::Unit& u, int wr, int wc, int fr, int fq) const {
        const int row0 = u.pm * 256 + wr * 64 + fr, col0 = u.pn * 256 + wc * 32 + 8 * fq;
        if (u.pn >= 3 && u.pn <= 5) {
#pragma unroll
            for (int bj = 0; bj < 2; ++bj) {
                const int ch0 = u.pn * 256 + bj * 128 - 768 + wc * 32 + 8 * fq;
                const float sc = ch0 >= 384 ? 0.10206207261596575f : 1.0f;
                float wv[4][8], bv[8];
#pragma unroll
                for (int tap = 0; tap < 4; ++tap) { const f32x4 a = *(const f32x4*)(convw + tap * 768 + ch0), b2 = *(const f32x4*)(convw + tap * 768 + ch0 + 4);
#pragma unroll
                    for (int i = 0; i < 4; ++i) { wv[tap][i] = a[i]; wv[tap][4 + i] = b2[i]; } }
                { const f32x4 a = *(const f32x4*)(convb + ch0), b2 = *(const f32x4*)(convb + ch0 + 4);
#pragma unroll
                  for (int i = 0; i < 4; ++i) { bv[i] = a[i]; bv[4 + i] = b2[i]; } }
#pragma unroll
                for (int ai = 0; ai < 2; ++ai) {
#pragma unroll
                    for (int m = 0; m < 4; ++m) {
                        float o[8];
#pragma unroll
                        for (int i = 0; i < 8; ++i) {
                            const float x0 = acc[ai][bj][m][i >> 2][i & 3];
                            const float xm1 = m > 0 ? acc[ai][bj][m > 0 ? m - 1 : 0][i >> 2][i & 3] : 0.f;
                            const float p1 = row_prev<1>(x0, xm1), p2 = row_prev<2>(x0, xm1), p3 = row_prev<3>(x0, xm1);
                            float y = bv[i];
                            y = __builtin_fmaf(wv[0][i], p3, y); y = __builtin_fmaf(wv[1][i], p2, y); y = __builtin_fmaf(wv[2][i], p1, y); y = __builtin_fmaf(wv[3][i], x0, y);
                            y = siluf_(y) * sc;
                            if (m == 0 && fr < 3) y = x0;
                            o[i] = y;
                        }
                        v4u w; w.x = pk2(o[0], o[1]); w.y = pk2(o[2], o[3]); w.z = pk2(o[4], o[5]); w.w = pk2(o[6], o[7]);
                        *(v4u*)(O + (size_t)(row0 + ai * 128 + m * 16) * NPJ + col0 + bj * 128) = w;
                        if (m == 3 && fr >= 13) {
                            const f32x4 v0 = acc[ai][bj][3][0], v1 = acc[ai][bj][3][1];
                            v4u hw; hw.x = pk2(v0[0], v0[1]); hw.y = pk2(v0[2], v0[3]); hw.z = pk2(v1[0], v1[1]); hw.w = pk2(v1[2], v1[3]);
                            *(v4u*)(halo + ((size_t)((4 * u.pm + 2 * ai + wr) * 3 + (fr - 13))) * 768 + ch0) = hw;
                        }
                    }
                }
            }
            return;
        }
        const unsigned long long SILU_M = (0x7ull << 18), SIGM_M = 0x7ull << 15;
        const int sg0 = 2 * u.pn, sg1 = sg0 + 1;
        const int act0 = ((SILU_M >> sg0) & 1) ? 2 : (((SIGM_M >> sg0) & 1) ? 3 : 0);
        const int act1 = ((SILU_M >> sg1) & 1) ? 2 : (((SIGM_M >> sg1) & 1) ? 3 : 0);
#pragma unroll
        for (int ai = 0; ai < 2; ++ai)
#pragma unroll
            for (int m = 0; m < 4; ++m) {
                bf16* rowp = O + (size_t)(row0 + ai * 128 + m * 16) * NPJ + col0;
#pragma unroll
                for (int bj = 0; bj < 2; ++bj) {
                    f32x4 v0 = acc[ai][bj][m][0], v1 = acc[ai][bj][m][1];
                    const int act = bj ? act1 : act0;
                    if (act) {
#pragma unroll
                        for (int i = 0; i < 4; ++i) { v0[i] = actf(v0[i], act); v1[i] = actf(v1[i], act); }
                    }
                    v4u w; w.x = pk2(v0[0], v0[1]); w.y = pk2(v0[2], v0[3]); w.z = pk2(v1[0], v1[1]); w.w = pk2(v1[2], v1[3]);
                    *(v4u*)(rowp + bj * 128) = w;
                }
            }
        if (u.pn == 16 && wc == 0 && fq == 0) {
#pragma unroll
            for (int ai = 0; ai < 2; ++ai)
#pragma unroll
                for (int m = 0; m < 4; ++m) {
                    float* g = gate + (size_t)(row0 + ai * 128 + m * 16) * 8;
                    *(f32x4*)g = acc[ai][1][m][0]; *(f32x4*)(g + 4) = acc[ai][1][m][1];
                }
        }
    }
};
struct EpiOut {
    static constexpr bool PERM = false, AFTER_DRAIN = false;
    const float* xin; float* out; const float* gatev;
    __device__ __forceinline__ void operator()(const f32x4 (&acc)[2][2][4][2], const pg8::Unit& u, int wr, int wc, int fr, int fq) const {
        const int row0 = u.pm * 256 + wr * 64 + fr, col0 = u.pn * 256 + wc * 32 + 4 * fq;
        const float* gp = gatev + (size_t)(u.pm >> 3) * 3072 + col0;
        f32x4 gv[2][2];
#pragma unroll
        for (int bj = 0; bj < 2; ++bj)
#pragma unroll
            for (int n = 0; n < 2; ++n) gv[bj][n] = *(const f32x4*)(gp + bj * 128 + n * 16);
#pragma unroll
        for (int ai = 0; ai < 2; ++ai)
#pragma unroll
            for (int m = 0; m < 4; ++m) {
                const size_t off = (size_t)(row0 + ai * 128 + m * 16) * DM + col0;
#pragma unroll
                for (int bj = 0; bj < 2; ++bj)
#pragma unroll
                    for (int n = 0; n < 2; ++n) {
                        const f32x4 xv = *(const f32x4*)(xin + off + bj * 128 + n * 16);
                        *(f32x4*)(out + off + bj * 128 + n * 16) = xv + gv[bj][n] * acc[ai][bj][m][n];
                    }
                asm volatile("" ::: "memory");
            }
    }
};

template <bool WIN>
__device__ __forceinline__ void p0_transpose_item(const float* W, int srcN, bf16* WT, LAS float* scr, int item, int nblk, int lane) {
    const int kb = item / nblk, nb = item % nblk, k0 = 64 * kb, n0 = 32 * nb;
    const int nd = n0 + (lane & 31);
    int sc = nd;
    if (WIN) { sc = nd < PSQ ? nd : (nd < PGI ? nd + 8 : (nd < DIN ? nd - PGI + 2688 : -1)); }
#pragma unroll 8
    for (int i = 0; i < 32; ++i) { const int kk = 2 * i + (lane >> 5); scr[kk * 33 + (lane & 31)] = sc >= 0 ? W[(size_t)(k0 + kk) * srcN + sc] : 0.f; }
    asm volatile("s_waitcnt lgkmcnt(0)" ::: "memory");
    const int c = lane & 7;
#pragma unroll
    for (int j = 0; j < 4; ++j) { const int n = (lane >> 3) + 8 * j; const LAS float* s = scr + (8 * c) * 33 + n;
        v4u o; o.x = pk2(s[0 * 33], s[1 * 33]); o.y = pk2(s[2 * 33], s[3 * 33]); o.z = pk2(s[4 * 33], s[5 * 33]); o.w = pk2(s[6 * 33], s[7 * 33]);
        *(v4u*)(WT + (size_t)(n0 + n) * DM + k0 + 8 * c) = o; }
    asm volatile("s_waitcnt lgkmcnt(0)" ::: "memory");
}

__device__ __forceinline__ void p0_phase(LAS unsigned char* lds, const float* c, const float* w_ada, const float* b_ada, const float* w_in, const float* w_out,
                                         float* mod, bf16* win_t, bf16* wout_t, int tid, int wid, int lane) {
    LAS float* cs = (LAS float*)lds;
    for (int unit = blockIdx.x; unit < 96; unit += gridDim.x) {
        const int l = unit / 48, nb = unit % 48;
        __syncthreads();
        for (int i = tid; i < 32 * 1024; i += 512) { const float cv = c[i]; cs[i] = siluf_(cv); }
        __syncthreads();
        const int n = nb * 64 + lane, kbase = wid * 128;
        const float* wp = w_ada + (size_t)l * 1024 * 3072 + (size_t)kbase * 3072 + n;
        float acc[32];
#pragma unroll
        for (int b = 0; b < 32; ++b) acc[b] = 0.f;
#pragma unroll 2
        for (int k = 0; k < 128; k += 4) {
            const float w0 = wp[(size_t)k * 3072], w1 = wp[(size_t)(k + 1) * 3072], w2 = wp[(size_t)(k + 2) * 3072], w3 = wp[(size_t)(k + 3) * 3072];
#pragma unroll
            for (int b = 0; b < 32; ++b) { const f32x4 cv = *(const LAS f32x4*)(cs + b * 1024 + kbase + k); acc[b] += cv[0] * w0 + cv[1] * w1 + cv[2] * w2 + cv[3] * w3; }
        }
        __syncthreads();
        LAS float* part = (LAS float*)lds;
#pragma unroll
        for (int b = 0; b < 32; ++b) part[(wid * 32 + b) * 64 + lane] = acc[b];
        __syncthreads();
        {
            const int nn = tid & 63, bg = tid >> 6;
#pragma unroll
            for (int bb = 0; bb < 4; ++bb) { const int b = bg * 4 + bb; float s = 0.f;
#pragma unroll
                for (int w = 0; w < 8; ++w) s += part[(w * 32 + b) * 64 + nn];
                mod[((size_t)l * 32 + b) * 3072 + nb * 64 + nn] = s + b_ada[l * 3072 + nb * 64 + nn]; }
        }
    }
    __syncthreads();
    LAS float* scr = (LAS float*)(lds + wid * 16384);
    int gw = blockIdx.x * 8 + wid, NGW = gridDim.x * 8;
    if (gridDim.x >= 192) { if (blockIdx.x < 96) return; gw -= 96 * 8; NGW -= 96 * 8; }
    constexpr int I_IN = 16 * (NPJ / 32), I_OUT = 16 * (DM / 32);
    for (int it = gw; it < 2 * (I_IN + I_OUT); it += NGW) {
        int r = it;
        if (r < 2 * I_IN) { const int l = r / I_IN; r -= l * I_IN; p0_transpose_item<true>(w_in + (size_t)l * DM * DIN, DIN, win_t + (size_t)l * WIN_ELEMS, scr, r, NPJ / 32, lane); }
        else { r -= 2 * I_IN; const int l = r / I_OUT; r -= l * I_OUT; p0_transpose_item<false>(w_out + (size_t)l * WOUT_ELEMS, DM, wout_t + (size_t)l * WOUT_ELEMS, scr, r, DM / 32, lane); }
    }
}

__device__ __forceinline__ void p1_phase(const float* xin, const float* g, const float* modl, bf16* H, int wid, int lane) {
    const int gw = blockIdx.x * 8 + wid, NGW = gridDim.x * 8;
    for (int base = gw * 32; base < MTOK; base += NGW * 32) {
        const int b = base >> 11;
        f32x4 gs[4], sh[4];
#pragma unroll
        for (int j = 0; j < 4; ++j) { const int k = 4 * lane + 256 * j;
            const f32x4 gg = *(const f32x4*)(g + k), sc = *(const f32x4*)(modl + (size_t)b * 3072 + 1024 + k);
            gs[j] = gg * (sc + 1.0f); sh[j] = *(const f32x4*)(modl + (size_t)b * 3072 + k); }
        for (int r = 0; r < 32; ++r) {
            const float* xr = xin + (size_t)(base + r) * DM + 4 * lane;
            f32x4 v[4]; float s = 0.f;
#pragma unroll
            for (int j = 0; j < 4; ++j) { v[j] = *(const f32x4*)(xr + 256 * j); s += (v[j][0] * v[j][0] + v[j][1] * v[j][1]) + (v[j][2] * v[j][2] + v[j][3] * v[j][3]); }
            const float rs = __builtin_amdgcn_rsqf(wave_sum(s) * (1.0f / DM) + EPSN);
            bf16* orow = H + (size_t)(base + r) * DM + 4 * lane;
#pragma unroll
            for (int j = 0; j < 4; ++j) { const f32x4 o = v[j] * rs * gs[j] + sh[j]; v2u w; w.x = pk2(o[0], o[1]); w.y = pk2(o[2], o[3]); *(v2u*)(orow + 256 * j) = w; }
        }
    }
}

__device__ __forceinline__ void attn_unit(LAS unsigned char* lds, const bf16* P, bf16* Y, const float* gq, const float* gk, int b, int h, int qb, int tid, int wid, int lane) {
    LAS bf16* Ks = (LAS bf16*)lds;
    LAS bf16* Vt = (LAS bf16*)(lds + 18432);
    volatile LAS int* flags = (volatile LAS int*)(lds + 35840);
    const int tq = lane & 15, quad = lane >> 4;
    const size_t row0 = (size_t)b * SEQ;
    const int t0 = qb * 128, t = t0 + 16 * wid + tq;
    const int sr = tid >> 3, dc = tid & 7, srv = tid & 127, dcv = tid >> 7;
    const bf16* kbase = P + (row0 + sr) * NPJ + PSK + h * 64 + 8 * dc;
    const bf16* vbase = P + (row0 + srv) * NPJ + PSV + h * 64 + 8 * dcv;
    v4u kwn[2], vwn[2];
    {
        const size_t adv = (size_t)(128 * qb) * NPJ;
        kwn[0] = *(const v4u*)(kbase + adv); kwn[1] = *(const v4u*)(kbase + adv + (size_t)64 * NPJ);
        vwn[0] = *(const v4u*)(vbase + adv); vwn[1] = *(const v4u*)(vbase + adv + 32);
    }
    bf16x8 Bq0, Bq1;
    {
        const bf16* qp = P + (row0 + t) * NPJ + PSQ + h * 64;
        const v4u q0 = *(const v4u*)(qp + 8 * quad), q1 = *(const v4u*)(qp + 32 + 8 * quad);
        float qf[16];
#pragma unroll
        for (int i = 0; i < 4; ++i) { qf[2 * i] = blo(q0[i]); qf[2 * i + 1] = bhi(q0[i]); qf[8 + 2 * i] = blo(q1[i]); qf[9 + 2 * i] = bhi(q1[i]); }
        float ss = 0.f;
#pragma unroll
        for (int i = 0; i < 16; ++i) ss += qf[i] * qf[i];
        ss += __shfl_xor(ss, 16); ss += __shfl_xor(ss, 32);
        const float rs = __builtin_amdgcn_rsqf(ss * (1.0f / 64.0f) + EPSN) * (0.125f * LOG2E);
        const f32x4 g0 = *(const f32x4*)(gq + 8 * quad), g1 = *(const f32x4*)(gq + 8 * quad + 4), g2 = *(const f32x4*)(gq + 32 + 8 * quad), g3 = *(const f32x4*)(gq + 36 + 8 * quad);
#pragma unroll
        for (int i = 0; i < 4; ++i) { qf[i] *= rs * g0[i]; qf[4 + i] *= rs * g1[i]; qf[8 + i] *= rs * g2[i]; qf[12 + i] *= rs * g3[i]; }
        Bq0 = mk8(pk2(qf[0], qf[1]), pk2(qf[2], qf[3]), pk2(qf[4], qf[5]), pk2(qf[6], qf[7]));
        Bq1 = mk8(pk2(qf[8], qf[9]), pk2(qf[10], qf[11]), pk2(qf[12], qf[13]), pk2(qf[14], qf[15]));
    }
    v2u zwp[4];
    {
        const bf16* zp = P + (row0 + t) * NPJ + PSZ + h * 64 + 4 * quad;
#pragma unroll
        for (int dt = 0; dt < 4; ++dt) zwp[dt] = *(const v2u*)(zp + 16 * dt);
    }
    f32x4 O[4];
#pragma unroll
    for (int i = 0; i < 4; ++i) O[i] = (f32x4){0.f, 0.f, 0.f, 0.f};
    float R = 1.0f;
    bool wdone = false;
    if (tid < 3) flags[tid] = 0;
    const int tg = 8 * qb + wid;
    const f32x4 gk0 = *(const f32x4*)(gk + 8 * dc), gk1 = *(const f32x4*)(gk + 8 * dc + 4);
    int it = 0;
    for (int kt = qb; kt >= 0; --kt, ++it) {
        {
            v4u kw[2], vw[2];
            kw[0] = kwn[0]; kw[1] = kwn[1]; vw[0] = vwn[0]; vw[1] = vwn[1];
            if (kt > 0) {
                const size_t adv = (size_t)(128 * (kt - 1)) * NPJ;
                kwn[0] = *(const v4u*)(kbase + adv); kwn[1] = *(const v4u*)(kbase + adv + (size_t)64 * NPJ);
                vwn[0] = *(const v4u*)(vbase + adv); vwn[1] = *(const v4u*)(vbase + adv + 32);
            }
#pragma unroll
            for (int hf = 0; hf < 2; ++hf) {
                float kf[8];
#pragma unroll
                for (int i = 0; i < 4; ++i) { kf[2 * i] = blo(kw[hf][i]); kf[2 * i + 1] = bhi(kw[hf][i]); }
                float ss = 0.f;
#pragma unroll
                for (int i = 0; i < 8; ++i) ss += kf[i] * kf[i];
                ss += __shfl_xor(ss, 1); ss += __shfl_xor(ss, 2); ss += __shfl_xor(ss, 4);
                const float rs = __builtin_amdgcn_rsqf(ss * (1.0f / 64.0f) + EPSN);
#pragma unroll
                for (int i = 0; i < 4; ++i) { kf[i] *= rs * gk0[i]; kf[4 + i] *= rs * gk1[i]; }
                v4u o; o.x = pk2(kf[0], kf[1]); o.y = pk2(kf[2], kf[3]); o.z = pk2(kf[4], kf[5]); o.w = pk2(kf[6], kf[7]);
                *(LAS v4u*)(Ks + (sr + 64 * hf) * 72 + 8 * dc) = o;
#pragma unroll
                for (int i = 0; i < 4; ++i) { Vt[(8 * (dcv + 4 * hf) + 2 * i) * 136 + srv] = (bf16)(vw[hf][i] & 0xffffu); Vt[(8 * (dcv + 4 * hf) + 2 * i + 1) * 136 + srv] = (bf16)(vw[hf][i] >> 16); }
            }
        }
        if (tid == 0) flags[(it + 1) % 3] = 0;
        LBAR();
        if (!wdone) {
#pragma unroll
            for (int p = 3; p >= 0; --p) {
                if (8 * kt + 2 * p <= tg && !wdone) {
                    float av[2][4];
#pragma unroll
                    for (int u = 1; u >= 0; --u) {
                        const int st = 2 * p + u, sg = 8 * kt + st;
                        if (sg > tg) {
#pragma unroll
                            for (int j = 0; j < 4; ++j) av[u][j] = 0.f;
                        } else {
                            const bf16x8 a0 = *(const LAS bf16x8*)(Ks + (16 * st + tq) * 72 + 8 * quad), a1 = *(const LAS bf16x8*)(Ks + (16 * st + tq) * 72 + 32 + 8 * quad);
                            f32x4 z = (f32x4){0.f, 0.f, 0.f, 0.f};
                            z = mfma16(a0, Bq0, z); z = mfma16(a1, Bq1, z);
                            float r[4], be[4];
#pragma unroll
                            for (int j = 0; j < 4; ++j) { const float e = fexp2(fminf(z[j], 80.f)); const float rr = frcp(1.0f + e); r[j] = rr; be[j] = e * rr; }
                            if (sg == tg) {
                                int tql = tq; asm volatile("" : "+v"(tql));
#pragma unroll
                                for (int j = 0; j < 4; ++j) if (4 * quad + j >= tql) { r[j] = 1.0f; be[j] = 0.f; }
                            }
                            const float x2 = r[3], x1 = x2 * r[2], x0 = x1 * r[1], T = x0 * r[0];
                            const float A_ = __shfl_xor(T, 16), Bp = T * A_, Cc = __shfl_xor(Bp, 32);
                            const float Xq = quad == 3 ? 1.0f : (quad == 2 ? A_ : (quad == 1 ? Cc : A_ * Cc));
                            const float Yv = Xq * R;
                            av[u][3] = be[3] * Yv; av[u][2] = be[2] * (x2 * Yv); av[u][1] = be[1] * (x1 * Yv); av[u][0] = be[0] * (x0 * Yv);
                            R *= Bp * Cc;
                        }
                    }
                    const bf16x8 Bf = mk8(pk2(av[0][0], av[0][1]), pk2(av[0][2], av[0][3]), pk2(av[1][0], av[1][1]), pk2(av[1][2], av[1][3]));
#pragma unroll
                    for (int dt = 0; dt < 4; ++dt) {
                        const v2u lo = *(const LAS v2u*)(Vt + (16 * dt + tq) * 136 + 32 * p + 4 * quad), hi = *(const LAS v2u*)(Vt + (16 * dt + tq) * 136 + 32 * p + 16 + 4 * quad);
                        O[dt] = mfma16(mk8(lo.x, lo.y, hi.x, hi.y), Bf, O[dt]);
                    }
                    if (__ballot(R >= 1e-20f) == 0ull) wdone = true;
                }
            }
            if (!wdone && lane == 0) flags[it % 3] = 1;
        }
        LBAR();
        if (flags[it % 3] == 0) break;
    }
    {
        bf16* yp = Y + (row0 + t) * DM + 640 + h * 64 + 4 * quad;
#pragma unroll
        for (int dt = 0; dt < 4; ++dt) {
            const v2u zw = zwp[dt];
            v2u w; w.x = pk2(O[dt][0] * siluf_(blo(zw.x)), O[dt][1] * siluf_(bhi(zw.x))); w.y = pk2(O[dt][2] * siluf_(blo(zw.y)), O[dt][3] * siluf_(bhi(zw.y)));
            *(v2u*)(yp + 16 * dt) = w;
        }
    }
}

__device__ __forceinline__ void gmlp_unit(LAS unsigned char* lds, const bf16* P, bf16* Y, const float* wsl, const float* bsl, const float* gvl, int b, int cq, int g, int tid, int wid, int lane) {
    LAS bf16* Ws = (LAS bf16*)lds;
    const int tq = lane & 15, quad = lane >> 4;
    {
        int tt = tid >> 2; asm volatile("" : "+v"(tt)); const int sc = (tid & 3) * 32;
        const float* src = wsl + ((size_t)(g * 128 + tt)) * 128 + sc;
#pragma unroll
        for (int q2 = 0; q2 < 4; ++q2) {
            f32x4 f0 = *(const f32x4*)(src + 8 * q2), f1 = *(const f32x4*)(src + 8 * q2 + 4);
#pragma unroll
            for (int i = 0; i < 4; ++i) { if (sc + 8 * q2 + i > tt) f0[i] = 0.f; if (sc + 8 * q2 + 4 + i > tt) f1[i] = 0.f; }
            v4u o; o.x = pk2(f0[0], f0[1]); o.y = pk2(f0[2], f0[3]); o.z = pk2(f1[0], f1[1]); o.w = pk2(f1[2], f1[3]);
            *(LAS v4u*)(Ws + tt * 136 + sc + 8 * q2) = o;
        }
    }
    const int s = tid >> 2, dq = (tid & 3) * 16, tt = 16 * wid + tq;
    const size_t tokb = (size_t)b * SEQ + 512 * cq;
    const bf16* vp = P + (tokb + s) * NPJ + PV + g * 64 + dq;
    const bf16* up = P + (tokb + tt) * NPJ + PU + g * 64 + 4 * quad;
    bf16* yp = Y + (tokb + tt) * DM + g * 64 + 4 * quad;
    const float bs = bsl[g * 128 + tt];
    v4u nv0 = *(const v4u*)vp, nv1 = *(const v4u*)(vp + 8);
    v2u nuw[4], nzw[4];
#pragma unroll
    for (int dt = 0; dt < 4; ++dt) { nuw[dt] = *(const v2u*)(up + 16 * dt); nzw[dt] = *(const v2u*)(up + (PZ - PU) + 16 * dt); }
#pragma unroll 1
    for (int c4 = 0; c4 < 4; ++c4) {
        LAS bf16* Vn = (LAS bf16*)(lds + 34816 + (c4 & 1) * 17408);
        const v4u v0 = nv0, v1 = nv1;
        v2u uw[4], zw[4];
#pragma unroll
        for (int dt = 0; dt < 4; ++dt) { uw[dt] = nuw[dt]; zw[dt] = nzw[dt]; }
        if (c4 < 3) {
            const size_t adv = (size_t)(128 * (c4 + 1)) * NPJ;
            nv0 = *(const v4u*)(vp + adv); nv1 = *(const v4u*)(vp + adv + 8);
#pragma unroll
            for (int dt = 0; dt < 4; ++dt) { nuw[dt] = *(const v2u*)(up + adv + 16 * dt); nzw[dt] = *(const v2u*)(up + adv + (PZ - PU) + 16 * dt); }
        }
        {
            float vf[16];
#pragma unroll
            for (int i = 0; i < 4; ++i) { vf[2 * i] = geluf_(blo(v0[i])); vf[2 * i + 1] = geluf_(bhi(v0[i])); vf[8 + 2 * i] = geluf_(blo(v1[i])); vf[9 + 2 * i] = geluf_(bhi(v1[i])); }
            float ss = 0.f;
#pragma unroll
            for (int i = 0; i < 16; ++i) ss += vf[i] * vf[i];
            ss += __shfl_xor(ss, 1); ss += __shfl_xor(ss, 2);
            const float rs = __builtin_amdgcn_rsqf(ss * (1.0f / 64.0f) + EPSN);
#pragma unroll
            for (int i = 0; i < 16; ++i) { const float o = vf[i] * rs * gvl[g * 64 + dq + i]; Vn[(dq + i) * 136 + s] = (bf16)(pk2(o, 0.f) & 0xffffu); }
        }
        LBAR();
        f32x4 acc[4];
#pragma unroll
        for (int i = 0; i < 4; ++i) acc[i] = (f32x4){0.f, 0.f, 0.f, 0.f};
#pragma unroll
        for (int kk = 0; kk < 4; ++kk) {
            if (kk <= (wid >> 1)) {
                const bf16x8 Bw = *(const LAS bf16x8*)(Ws + tt * 136 + 32 * kk + 8 * quad);
#pragma unroll
                for (int dt = 0; dt < 4; ++dt) { const bf16x8 Av = *(const LAS bf16x8*)(Vn + (16 * dt + tq) * 136 + 32 * kk + 8 * quad); acc[dt] = mfma16(Av, Bw, acc[dt]); }
            }
        }
        bf16* ypc = yp + (size_t)(128 * c4) * DM;
#pragma unroll
        for (int dt = 0; dt < 4; ++dt) {
            const float y0 = geluf_(blo(uw[dt].x)) * (acc[dt][0] + bs) * siluf_(blo(zw[dt].x)), y1 = geluf_(bhi(uw[dt].x)) * (acc[dt][1] + bs) * siluf_(bhi(zw[dt].x));
            const float y2 = geluf_(blo(uw[dt].y)) * (acc[dt][2] + bs) * siluf_(blo(zw[dt].y)), y3 = geluf_(bhi(uw[dt].y)) * (acc[dt][3] + bs) * siluf_(bhi(zw[dt].y));
            v2u w; w.x = pk2(y0, y1); w.y = pk2(y2, y3);
            *(v2u*)(ypc + 16 * dt) = w;
        }
    }
}

constexpr int ML_QS = 0, ML_KS = 26624, ML_KTS = 53248, ML_VTS = 79360, ML_CB = 109824, ML_GA = 133120, ML_GSTRIDE = 2688, ML_CW = 138496;
#define ML_ISSUE_LOADS(cc, TT)                                                                                                           \
    do {                                                                                                                                    \
        _Pragma("unroll") for (int itx = 0; itx < 3; ++itx) { const int idx = (TT) + 512 * itx, tk = idx / 12, dcx = idx - 12 * tk;         \
            const bf16* xp = P + (row0 + 128 * (cc) + tk) * NPJ + PMQ + h * 96 + 8 * dcx;                                                   \
            rq[itx] = *(const v4u*)xp; rk[itx] = *(const v4u*)(xp + (PMK - PMQ)); }                                                         \
        _Pragma("unroll") for (int itx = 0; itx < 3; ++itx) { const int idx = (TT) + 512 * itx, tk = idx & 127, dcx = idx >> 7;             \
            vv[itx] = *(const v4u*)(P + (row0 + 128 * (cc) + tk) * NPJ + PMV + h * 96 + 8 * dcx); }                                         \
        if ((TT) < 144) {                                                                                                                   \
            const int fi = (TT) / 24, rem = (TT) - 24 * fi, qk = rem / 12, dcx = rem - 12 * qk, jj = fi % 3, lr = (fi >= 3 ? 64 : 0) + jj;  \
            const int pp = 128 * (cc) + lr;                                                                                                 \
            const size_t colp = (size_t)(qk ? PMK : PMQ) + h * 96 + 8 * dcx;                                                                \
            const bf16* hb = HB + ((size_t)((row0 + pp) / 64) - 1) * 3 * 768 + qk * 384 + h * 96 + 8 * dcx;                                 \
            _Pragma("unroll") for (int d = 0; d < 4; ++d) {                                                                                 \
                v4u val = (v4u){0u, 0u, 0u, 0u};                                                                                            \
                if (pp - d >= 0) { if (d <= jj) val = *(const v4u*)(P + (row0 + pp - d) * NPJ + colp); else val = *(const v4u*)(hb + (size_t)(3 + jj - d) * 768); } \
                fx[3 - d] = val;                                                                                                            \
            }                                                                                                                               \
        }                                                                                                                                   \
    } while (0)
#define ML_GATES(cc, LN)                                                                                                                   \
    do {                                                                                                                                    \
        LAS float* GBw = (LAS float*)(lds + ML_GA + ((cc) & 1) * ML_GSTRIDE);                                                               \
        const int s0 = 2 * (LN);                                                                                                            \
        const float i0 = gi0 + bih, f0 = gf0 + bfh, i1 = gi1 + bih, f1 = gf1 + bfh;                                                         \
        if ((cc) < 15) { const float* gp = gate + (row0 + 128 * ((cc) + 1) + s0) * 8; gi0 = gp[h]; gf0 = gp[4 + h]; gi1 = gp[8 + h]; gf1 = gp[12 + h]; } \
        const float lf0 = logsigf_(f0), lf1 = logsigf_(f1);                                                                                 \
        const float p = lf0 + lf1; float inc = p;                                                                                           \
        _Pragma("unroll") for (int off = 1; off < 64; off <<= 1) { const float v = __shfl_up(inc, off); if ((LN) >= off) inc += v; }        \
        const float bc0 = (inc - p) + lf0, bc1 = inc;                                                                                       \
        const float a0 = i0 - bc0, a1 = i1 - bc1;                                                                                           \
        float incm = fmaxf(a0, a1);                                                                                                         \
        _Pragma("unroll") for (int off = 1; off < 64; off <<= 1) { const float v = __shfl_up(incm, off); if ((LN) >= off) incm = fmaxf(incm, v); } \
        float excm = __shfl_up(incm, 1); if ((LN) == 0) excm = -INFINITY;                                                                   \
        const float M0 = fmaxf(m_prev, fmaxf(excm, a0)), M1 = fmaxf(m_prev, incm);                                                          \
        const float M127 = __shfl(M1, 63), btot = __shfl(bc1, 63);                                                                          \
        GBw[s0] = a0 * LOG2E; GBw[s0 + 1] = a1 * LOG2E; GBw[128 + s0] = M0 * LOG2E; GBw[129 + s0] = M1 * LOG2E;                             \
        GBw[256 + s0] = fexp(m_prev - M0); GBw[257 + s0] = fexp(m_prev - M1);                                                               \
        GBw[384 + s0] = fexp(-(bc0 + M0)); GBw[385 + s0] = fexp(-(bc1 + M1));                                                               \
        GBw[512 + s0] = fexp(a0 - M127); GBw[513 + s0] = fexp(a1 - M127);                                                                   \
        if ((LN) == 0) GBw[640] = fexp(m_prev - M127);                                                                                      \
        m_prev = btot + M127;                                                                                                               \
    } while (0)
__device__ __forceinline__ void mlstm_unit(LAS unsigned char* lds, const bf16* P, const bf16* HB, const float* gate, bf16* Y, const float* convw, const float* convb, const float* bi, const float* bfv, const float* hn,
                                           int b, int h, int tid, int wid, int lane, const int mode = 0) {
    LAS bf16* QS = (LAS bf16*)(lds + ML_QS);
    LAS bf16* KS = (LAS bf16*)(lds + ML_KS);
    LAS bf16* KTS = (LAS bf16*)(lds + ML_KTS);
    LAS bf16* VTS = (LAS bf16*)(lds + ML_VTS);
    LAS bf16* CB = (LAS bf16*)(lds + ML_CB);
    const int tq = lane & 15, quad = lane >> 4;
    const size_t row0 = (size_t)b * SEQ;
    for (int i = tid; i < 112 * 104 / 2; i += 512) ((LAS unsigned*)CB)[i] = 0u;
    for (int i = tid; i < 16 * 136; i += 512) VTS[96 * 136 + i] = (i < 136) ? (bf16)0x3F80 : (bf16)0;
    LAS float* CW = (LAS float*)(lds + ML_CW);
    for (int i = tid; i < 960; i += 512) { const int qk = i / 480, r = i - 480 * qk, tap = r / 96, ch = r - 96 * tap; CW[i] = tap < 4 ? convw[tap * 768 + qk * 384 + h * 96 + ch] : convb[qk * 384 + h * 96 + ch]; }
    f32x4 Cm[6];
#pragma unroll
    for (int i = 0; i < 6; ++i) Cm[i] = (f32x4){0.f, 0.f, 0.f, 0.f};
    float m_prev = 0.f;
    const float bih = bi[h], bfh = bfv[h];
    __syncthreads();
    float gi0 = 0.f, gf0 = 0.f, gi1 = 0.f, gf1 = 0.f;
    if (wid == 0) { const float* gp = gate + (row0 + 2 * lane) * 8; gi0 = gp[h]; gf0 = gp[4 + h]; gi1 = gp[8 + h]; gf1 = gp[12 + h]; }
    if (wid == 0 && !(mode & 16)) ML_GATES(0, lane);
    v4u rq[3], rk[3], fx[4]; v4u vv[3];
#pragma unroll
    for (int d = 0; d < 4; ++d) fx[d] = (v4u){0u, 0u, 0u, 0u};
    ML_ISSUE_LOADS(0, tid);
    for (int c = 0; c < 16; ++c) {
        const size_t tok0 = row0 + 128 * c;
        int tidc = tid, lanec = lane; asm volatile("" : "+v"(tidc), "+v"(lanec));
        const int tq = lanec & 15, quad = lanec >> 4;
        LAS float* GA = (LAS float*)(lds + ML_GA + (c & 1) * ML_GSTRIDE); LAS float* GM = GA + 128; LAS float* GWI = GA + 256; LAS float* GFL = GA + 384; LAS float* GWS = GA + 512; LAS float* GSC = GA + 640;
#pragma unroll
        for (int itx = 0; itx < 3; ++itx) { const int idx = tidc + 512 * itx, tk = idx / 12, dcx = idx - 12 * tk;
            if ((tk & 63) >= 3) { *(LAS v4u*)(QS + tk * 104 + 8 * dcx) = rq[itx]; *(LAS v4u*)(KS + tk * 104 + 8 * dcx) = rk[itx]; } }
        if (tidc < 144) {
            const int fi = tidc / 24, rem = tidc - 24 * fi, qk = rem / 12, dcx = rem - 12 * qk, lr = (fi >= 3 ? 64 : 0) + fi % 3;
            const LAS float* cwp = CW + qk * 480 + 8 * dcx;
            const f32x4 cb0 = *(const LAS f32x4*)(cwp + 384), cb1 = *(const LAS f32x4*)(cwp + 388);
            f32x4 a0 = cb0, a1 = cb1;
#pragma unroll
            for (int tap = 0; tap < 4; ++tap) {
                const f32x4 w0 = *(const LAS f32x4*)(cwp + tap * 96), w1 = *(const LAS f32x4*)(cwp + tap * 96 + 4);
                const v4u xw = fx[tap];
                a0[0] = __builtin_fmaf(w0[0], blo(xw.x), a0[0]); a0[1] = __builtin_fmaf(w0[1], bhi(xw.x), a0[1]); a0[2] = __builtin_fmaf(w0[2], blo(xw.y), a0[2]); a0[3] = __builtin_fmaf(w0[3], bhi(xw.y), a0[3]);
                a1[0] = __builtin_fmaf(w1[0], blo(xw.z), a1[0]); a1[1] = __builtin_fmaf(w1[1], bhi(xw.z), a1[1]); a1[2] = __builtin_fmaf(w1[2], blo(xw.w), a1[2]); a1[3] = __builtin_fmaf(w1[3], bhi(xw.w), a1[3]);
            }
            const float sc = qk ? 0.10206207261596575f : 1.0f;
            v4u o;
            o.x = pk2(siluf_(a0[0]) * sc, siluf_(a0[1]) * sc); o.y = pk2(siluf_(a0[2]) * sc, siluf_(a0[3]) * sc);
            o.z = pk2(siluf_(a1[0]) * sc, siluf_(a1[1]) * sc); o.w = pk2(siluf_(a1[2]) * sc, siluf_(a1[3]) * sc);
            *(LAS v4u*)((qk ? KS : QS) + lr * 104 + 8 * dcx) = o;
        }
#pragma unroll
        for (int itx = 0; itx < 3; ++itx) {
            if (mode & 2) { if (vv[itx][0] == 0x12345678u) VTS[tidc] = 1; continue; }
            const int idx = tidc + 512 * itx, tk = idx & 127, dcx = idx >> 7;
#pragma unroll
            for (int i = 0; i < 4; ++i) { VTS[(8 * dcx + 2 * i) * 136 + tk] = (bf16)(vv[itx][i] & 0xffffu); VTS[(8 * dcx + 2 * i + 1) * 136 + tk] = (bf16)(vv[itx][i] >> 16); }
        }
        LBAR();
        v2u owp[6], zwp[6];
        {
            const bf16* op = P + (tok0 + 16 * wid + tq) * NPJ + PMO + h * 96 + 4 * quad;
#pragma unroll
            for (int et = 0; et < 6; ++et) { owp[et] = *(const v2u*)(op + 16 * et); zwp[et] = *(const v2u*)(op + (PMZ - PMO) + 16 * et); }
        }
        if (c < 15) ML_ISSUE_LOADS(c + 1, tidc);
#pragma unroll
        for (int itx = 0; itx < 3; ++itx) {
            if (mode & 2) break;
            const int idx = tidc + 512 * itx, s = idx & 127, dcx = idx >> 7;
            const v4u kw = *(const LAS v4u*)(KS + s * 104 + 8 * dcx);
            const float wv = GWS[s];
#pragma unroll
            for (int i = 0; i < 4; ++i) { const unsigned pw = pk2(blo(kw[i]) * wv, bhi(kw[i]) * wv); KTS[(8 * dcx + 2 * i) * 136 + s] = (bf16)(pw & 0xffffu); KTS[(8 * dcx + 2 * i + 1) * 136 + s] = (bf16)(pw >> 16); }
        }
        if (!(mode & 4)) {
            const int tt = 16 * wid + tq;
            bf16x8 Bq[3];
#pragma unroll
            for (int kk = 0; kk < 3; ++kk) Bq[kk] = *(const LAS bf16x8*)(QS + tt * 104 + 32 * kk + 8 * quad);
            f32x4 acc[7];
            const float wi = GWI[tt];
#pragma unroll
            for (int et = 0; et < 7; ++et) {
                f32x4 a = (f32x4){0.f, 0.f, 0.f, 0.f};
#pragma unroll
                for (int kk = 0; kk < 3; ++kk) a = mfma16(*(const LAS bf16x8*)(CB + (16 * et + tq) * 104 + 32 * kk + 8 * quad), Bq[kk], a);
                acc[et] = a * wi;
            }
            const float Mt2 = GM[tt];
            int ttl = tt; asm volatile("" : "+v"(ttl));
#pragma unroll
            for (int p = 0; p < 4; ++p) {
                if (2 * p <= wid) {
                    float sv[2][4];
#pragma unroll
                    for (int u = 0; u < 2; ++u) {
                        const int st = 2 * p + u;
                        if (st > wid) {
#pragma unroll
                            for (int j = 0; j < 4; ++j) sv[u][j] = 0.f;
                        } else {
                            f32x4 z = (f32x4){0.f, 0.f, 0.f, 0.f};
#pragma unroll
                            for (int kk = 0; kk < 3; ++kk) z = mfma16(*(const LAS bf16x8*)(KS + (16 * st + tq) * 104 + 32 * kk + 8 * quad), Bq[kk], z);
                            const f32x4 a4 = *(const LAS f32x4*)(GA + 16 * st + 4 * quad);
#pragma unroll
                            for (int j = 0; j < 4; ++j) { float val = z[j] * fexp2(a4[j] - Mt2); if (16 * st + 4 * quad + j > ttl) val = 0.f; sv[u][j] = val; }
                        }
                    }
                    const bf16x8 Bf = mk8(pk2(sv[0][0], sv[0][1]), pk2(sv[0][2], sv[0][3]), pk2(sv[1][0], sv[1][1]), pk2(sv[1][2], sv[1][3]));
#pragma unroll
                    for (int et = 0; et < 7; ++et) {
                        const v2u lo = *(const LAS v2u*)(VTS + (16 * et + tq) * 136 + 32 * p + 4 * quad), hi = *(const LAS v2u*)(VTS + (16 * et + tq) * 136 + 32 * p + 16 + 4 * quad);
                        acc[et] = mfma16(mk8(lo.x, lo.y, hi.x, hi.y), Bf, acc[et]);
                    }
                }
            }
            const float den = __shfl(acc[6][0], tq);
            const float inv = 1.0f / fmaxf(fabsf(den), GFL[tt]);
            float ss = 0.f;
#pragma unroll
            for (int et = 0; et < 6; ++et) { acc[et] = acc[et] * inv; ss += (acc[et][0] * acc[et][0] + acc[et][1] * acc[et][1]) + (acc[et][2] * acc[et][2] + acc[et][3] * acc[et][3]); }
            ss += __shfl_xor(ss, 16); ss += __shfl_xor(ss, 32);
            const float rs = __builtin_amdgcn_rsqf(ss * (1.0f / 96.0f) + EPSN);
            const size_t row = tok0 + tt;
            bf16* yp = Y + row * DM + 256 + h * 96 + 4 * quad;
#pragma unroll
            for (int et = 0; et < 6; ++et) {
                const v2u ow = owp[et], zw = zwp[et];
                const f32x4 hv = *(const f32x4*)(hn + h * 96 + 16 * et + 4 * quad);
                const float y0 = acc[et][0] * rs * hv[0] * blo(ow.x) * blo(zw.x), y1 = acc[et][1] * rs * hv[1] * bhi(ow.x) * bhi(zw.x);
                const float y2 = acc[et][2] * rs * hv[2] * blo(ow.y) * blo(zw.y), y3 = acc[et][3] * rs * hv[3] * bhi(ow.y) * bhi(zw.y);
                v2u w; w.x = pk2(y0, y1); w.y = pk2(y2, y3);
                *(v2u*)(yp + 16 * et) = w;
            }
        }
        if (wid == 0 && c < 15 && !(mode & 16)) ML_GATES(c + 1, lanec);
        LBAR();
        if (!(mode & 8)) {
            const float decay = GSC[0];
#pragma unroll
            for (int i = 0; i < 6; ++i) {
                const int idx = wid + 8 * i;
                if (idx < 42) {
                    const int et = idx / 6, dtl = idx - 6 * et;
                    f32x4 tmp = (f32x4){0.f, 0.f, 0.f, 0.f};
#pragma unroll
                    for (int kk = 0; kk < 4; ++kk)
                        tmp = mfma16(*(const LAS bf16x8*)(VTS + (16 * et + tq) * 136 + 32 * kk + 8 * quad), *(const LAS bf16x8*)(KTS + (16 * dtl + tq) * 136 + 32 * kk + 8 * quad), tmp);
                    Cm[i] = Cm[i] * decay + tmp;
#pragma unroll
                    for (int j = 0; j < 4; ++j) CB[(16 * et + 4 * quad + j) * 104 + 16 * dtl + tq] = (bf16)(pk2(Cm[i][j], 0.f) & 0xffffu);
                }
            }
        }
        LBAR();
    }
}

struct LayerP {
    const float *gv, *gws, *gbs, *convw, *convb, *bi, *bfv, *hn, *gq, *gk; const bf16* halo;
};
__device__ __forceinline__ int p3_fetch_(volatile LAS int* s_unit, unsigned* counter, int tid, int& pre) {
    __syncthreads();
    if (tid == 0) s_unit[0] = pre;
    __syncthreads();
    const int u = __builtin_amdgcn_readfirstlane(s_unit[0]);
    if (tid == 0) pre = (int)atomicAdd(counter, 1u);
    return u;
}
__device__ __forceinline__ void p3_phase(LAS unsigned char* lds, const bf16* P, const float* gate, bf16* Y, const LayerP& lp, unsigned* counter, int tid, int wid, int lane, const int ubase = 0, const int uend = N_UNITS, const int mode = 0) {
    volatile LAS int* s_unit = (volatile LAS int*)(lds + LDS_BYTES - 64);
#define p3_fetch(a_, b_, c_) (ubase + p3_fetch_(a_, b_, c_, pre))
    int pre = 0; if (tid == 0) pre = (int)atomicAdd(counter, 1u);
    int u = p3_fetch(s_unit, counter, tid);
#ifndef SKIP_ML
    while (u < N_ML && u < uend) { mlstm_unit(lds, P, lp.halo, gate, Y, lp.convw, lp.convb, lp.bi, lp.bfv, lp.hn, u >> 2, u & 3, tid, wid, lane, mode); u = p3_fetch(s_unit, counter, tid); }
#endif
#ifndef SKIP_AT
    while (u < N_ML + N_AT && u < uend) { const int idx = u - N_ML, qb = 15 - idx / 192, rem = idx % 192; attn_unit(lds, P, Y, lp.gq, lp.gk, rem / 6, rem % 6, qb, tid, wid, lane); u = p3_fetch(s_unit, counter, tid); }
#endif
#ifndef SKIP_GM
    while (u < uend) { const int idx = u - N_ML - N_AT; gmlp_unit(lds, P, Y, lp.gws, lp.gbs, lp.gv, idx >> 4, (idx >> 2) & 3, idx & 3, tid, wid, lane); u = p3_fetch(s_unit, counter, tid); }
#endif
#undef p3_fetch
}

__device__ __forceinline__ void fast_grid_barrier(unsigned* base, int seam, int tid) {
    asm volatile("s_waitcnt vmcnt(0)" ::: "memory");
    __syncthreads();
    if (tid == 0) {
        unsigned* cnt = base + seam * 128;
        unsigned* flg = cnt + 64;
        __builtin_amdgcn_fence(__ATOMIC_RELEASE, "agent");
        asm volatile("s_waitcnt vmcnt(0)" ::: "memory");
        const unsigned old = __hip_atomic_fetch_add(cnt, 1u, __ATOMIC_RELAXED, __HIP_MEMORY_SCOPE_AGENT);
        if (old == gridDim.x - 1) __hip_atomic_store(flg, 1u, __ATOMIC_RELAXED, __HIP_MEMORY_SCOPE_AGENT);
        else { unsigned sp = 0; while (__hip_atomic_load(flg, __ATOMIC_RELAXED, __HIP_MEMORY_SCOPE_AGENT) == 0u) { __builtin_amdgcn_s_sleep(2); if (++sp > (1u << 22)) break; } }
        __builtin_amdgcn_fence(__ATOMIC_ACQUIRE, "agent");
        asm volatile("s_waitcnt vmcnt(0)" ::: "memory");
    }
    __syncthreads();
}

#ifndef P3_WID
#define P3_WID wid
#endif
#ifndef DUP_MODE
#define DUP_MODE 0
#endif
struct Args { const float* in[17]; float* out; unsigned char* ws; int ph_lo, ph_hi; };
struct RowOrder {
    int c;
    __device__ __forceinline__ bool next(int i, pg8::Unit& u) const { if (i >= DM / 256) return false; u.pm = c; u.pn = i; return true; }
    __device__ __forceinline__ void a_ready(const pg8::Unit&) const {}
    __device__ __forceinline__ void done(const pg8::Unit&) const {}
};
typedef const __attribute__((address_space(4))) Args* KArgP;
template <int PH>
__device__ __forceinline__ void run_phase(LAS unsigned char* lds, int tid, int wid, int lane) {
#if defined(__HIP_DEVICE_COMPILE__)
    KArgP ap = (KArgP)__builtin_amdgcn_kernarg_segment_ptr(); asm volatile("" : "+s"(ap));
    const Args a = *ap;
#else
    const Args a{};
#endif
    unsigned char* ws = a.ws;
    float* mod = (float*)(ws + WS_MOD); float* gate = (float*)(ws + WS_GATE);
    bf16* win_t = (bf16*)(ws + WS_WIN); bf16* wout_t = (bf16*)(ws + WS_WOUT);
    bf16* H = (bf16*)(ws + WS_H); bf16* PJ = (bf16*)(ws + WS_PROJ);
    if constexpr (PH == 0) {
#ifndef SKIP_P0
        p0_phase(lds, a.in[1], a.in[3], a.in[4], a.in[5], a.in[16], mod, win_t, wout_t, tid, wid, lane);
#endif
    } else {
        constexpr int l = (PH - 1) >> 2, sub = (PH - 1) & 3;
        const float* xin = l == 0 ? a.in[0] : a.out;
        if constexpr (sub == 0) {
#ifndef SKIP_P1
            p1_phase(xin, a.in[2] + l * DM, mod + (size_t)l * 32 * 3072, H, wid, lane);
#endif
        } else if constexpr (sub == 1) {
#ifndef SKIP_G1
            pg8::Gemm g{H, win_t + (size_t)l * WIN_ELEMS, MTOK, NPJ, DM}; pg8::StaticOrder S; S.init(MTOK, NPJ, (int)gridDim.x, (int)blockIdx.x);
            EpiProj E{PJ, gate, a.in[9] + l * 4 * 768, a.in[10] + l * 768, (bf16*)(ws + WS_HALO)};
            pg8::gemm_phase<EpiProj, pg8::StaticOrder, true, true>(lds, g, S, E);
#if defined(DUP_P2)
            if (l == 0) { __syncthreads(); pg8::gemm_phase<EpiProj, pg8::StaticOrder, true, true>(lds, g, S, E); }
#endif
#endif
        } else if constexpr (sub == 2) {
            LayerP lp;
            lp.gv = a.in[6] + l * 256; lp.gws = a.in[7] + (size_t)l * 4 * 128 * 128; lp.gbs = a.in[8] + l * 512; lp.convw = a.in[9] + l * 4 * 768; lp.convb = a.in[10] + l * 768;
            lp.bi = a.in[11] + l * 4; lp.bfv = a.in[12] + l * 4; lp.hn = a.in[13] + l * 384; lp.gq = a.in[14] + l * 64; lp.gk = a.in[15] + l * 64; lp.halo = (const bf16*)(ws + WS_HALO);
            p3_phase(lds, PJ, gate, H, lp, (unsigned*)(ws + WS_CTL) + 64 * l, tid, P3_WID, lane);
#if defined(DUP_P3)
            if (l == 0) { __syncthreads(); p3_phase(lds, PJ, gate, (bf16*)(ws + 800 * MiB), lp, (unsigned*)(ws + WS_CTL) + 64 * (l + 2), tid, P3_WID, lane, DUP_LO, DUP_HI, DUP_MODE); }
#endif
        } else {
#ifndef SKIP_G2
            pg8::Gemm g{H, wout_t + (size_t)l * WOUT_ELEMS, MTOK, DM, DM};
            EpiOut E{xin, a.out, mod + (size_t)l * 32 * 3072 + 2048};
            if (false && l == 0 && gridDim.x == MTOK / 256) {
                RowOrder S{(int)blockIdx.x};
                pg8::gemm_phase<EpiOut, RowOrder, true, true>(lds, g, S, E);
                asm volatile("s_waitcnt vmcnt(0)" ::: "memory");
                __syncthreads();
                __builtin_amdgcn_fence(__ATOMIC_ACQUIRE, "agent");
                p1_phase(a.out, a.in[2] + DM, mod + (size_t)32 * 3072, H, wid, lane);
            } else {
                pg8::StaticOrder S; S.init(MTOK, DM, (int)gridDim.x, (int)blockIdx.x);
                pg8::gemm_phase<EpiOut, pg8::StaticOrder, true, true>(lds, g, S, E);
            }
#endif
        }
    }
}
__global__ void __launch_bounds__(512, 2) hybrid_fwd(Args a) {
    extern __shared__ __attribute__((aligned(16))) unsigned char lds_raw[];
    LAS unsigned char* lds = (LAS unsigned char*)lds_raw;
    const int tid = threadIdx.x, lane = tid & 63, wid = __builtin_amdgcn_readfirstlane(tid >> 6);
    const int lo = a.ph_lo, hi = a.ph_hi;
#define IN(k) (lo <= (k) && (k) < hi)
#ifdef DUP_SYNC
#define EXTRA_SYNC() do { cg::this_grid().sync(); cg::this_grid().sync(); } while (0)
#else
#define EXTRA_SYNC() do { } while (0)
#endif
#define SEAM(k) fast_grid_barrier((unsigned*)(a.ws + 1024), (k), tid)
#define PHASE(k) do { if (IN(k)) { run_phase<k>(lds, tid, wid, lane); if (IN((k) + 1)) { SEAM(k); EXTRA_SYNC(); } } } while (0)
    if (hi > NPHASE) cg::this_grid().sync();
    const bool fused45 = false && (gridDim.x == MTOK / 256) && IN(4) && IN(5);
    PHASE(0); PHASE(1); PHASE(2); PHASE(3);
    if (fused45) { run_phase<4>(lds, tid, wid, lane); if (IN(6)) SEAM(5); }
    else { PHASE(4); PHASE(5); }
    PHASE(6); PHASE(7); PHASE(8);
#undef PHASE
#undef IN
}

extern "C" void kernel_launch(void* const* d_in, const int* in_sizes, int n_in, void* d_out, int out_size, void* d_ws, size_t ws_size, hipStream_t stream) {
    static int grid = 0;
    if (grid == 0) {
        if (n_in != 17 || out_size != MTOK * DM || ws_size < WS_END) { fprintf(stderr, "kernel_launch: unexpected shapes (n_in %d out %d ws %zu)\n", n_in, out_size, ws_size); grid = -1; return; }
        int dev = 0, cus = 0, per_cu = 0;
        (void)hipGetDevice(&dev);
        (void)hipDeviceGetAttribute(&cus, hipDeviceAttributeMultiprocessorCount, dev);
        if (hipFuncSetAttribute((const void*)hybrid_fwd, hipFuncAttributeMaxDynamicSharedMemorySize, LDS_BYTES) != hipSuccess) { fprintf(stderr, "kernel_launch: hipFuncSetAttribute failed\n"); }
        if (hipOccupancyMaxActiveBlocksPerMultiprocessor(&per_cu, (const void*)hybrid_fwd, 512, LDS_BYTES) != hipSuccess || per_cu < 1) { fprintf(stderr, "kernel_launch: occupancy query gave %d\n", per_cu); per_cu = 1; }
        (void)hipGetLastError();
        if (cus <= 0) cus = 256;
        grid = cus * 1;
        (void)per_cu;
    }
    if (grid < 0) return;
    (void)hipMemsetAsync((char*)d_ws + WS_CTL, 0, 8192, stream);
    Args a{};
    for (int i = 0; i < 17; ++i) a.in[i] = (const float*)d_in[i];
    a.out = (float*)d_out; a.ws = (unsigned char*)d_ws;
#if ONE_LAUNCH
    a.ph_lo = 0; a.ph_hi = NPHASE;
    void* args[] = {&a};
    hipError_t e = hipLaunchCooperativeKernel((const void*)hybrid_fwd, dim3(grid), dim3(512), args, LDS_BYTES, stream);
    if (e != hipSuccess) fprintf(stderr, "cooperative launch failed: %s (grid %d)\n", hipGetErrorString(e), grid);
#else
    for (int ph = 0; ph < NPHASE; ++ph) {
        a.ph_lo = ph; a.ph_hi = ph + 1;
        hipLaunchKernelGGL(hybrid_fwd, dim3(grid), dim3(512), LDS_BYTES, stream, a);
    }
#endif
}
```

```cpp
#include <hip/hip_runtime.h>
#include <hip/hip_cooperative_groups.h>
#include <cstdio>
#include <cstdint>
namespace cg = cooperative_groups;
#ifndef ONE_LAUNCH
#define ONE_LAUNCH 1
#endif
namespace pg8 {
#define PG8_LAS __attribute__((address_space(3)))
typedef unsigned short bf16_t;
typedef short bf16x8 __attribute__((ext_vector_type(8)));
typedef float f32x4 __attribute__((ext_vector_type(4)));
typedef unsigned u32x4 __attribute__((ext_vector_type(4)));
constexpr int BM = 256, BK = 64, HALF = 128, HTB = HALF * BK * 2  , STAGE_BYTES = 8 * HTB, NXCD = 8, WGM = 8;

__host__ __device__ __forceinline__ int lds_byte(int r, int c) { const int st = (r >> 4) * 2 + (c >> 5), rr = r & 15, cc = c & 31, ob = rr * 64 + cc * 2; return st * 1024 + (ob ^ (((ob >> 9) & 1) << 5)); }
__host__ __device__ __forceinline__ void stage_rc(int b, int& R, int& C) { const int st = b / 1024, sb = b % 1024, swz = sb ^ (((sb >> 9) & 1) << 5); R = (st >> 1) * 16 + swz / 64; C = (st & 1) * 32 + (swz % 64) / 2; }
__host__ __device__ __forceinline__ int perm32(int rho) { const int n = rho >> 4, i = rho & 15; return 8 * (i >> 2) + 4 * n + (i & 3); }

struct Unit { int pm, pn; };
struct Gemm { const bf16_t* A; const bf16_t* Bt; int M, N, K; };

struct StaticOrder {
    int nM, nN, nwg, G, c;
    __host__ __device__ void init(int M, int N, int G_, int c_) { nM = M / BM; nN = N / BM; nwg = nM * nN; G = G_; c = c_; }
    __host__ __device__ bool next(int i, Unit& u) const {
        const long L = (long)i * G + c; if (L >= nwg) return false;
        int wgid = (int)L; { const int q = nwg / NXCD, r = nwg % NXCD, xcd = wgid % NXCD, off = wgid / NXCD; wgid = (xcd < r ? xcd * (q + 1) : r * (q + 1) + (xcd - r) * q) + off; }
        const int nig = WGM * nN, gid = wgid / nig, fm = gid * WGM, gsz = (nM - fm) < WGM ? (nM - fm) : WGM;
        u.pm = fm + ((wgid % nig) % gsz); u.pn = (wgid % nig) / gsz; return true;
    }
    __device__ __forceinline__ void a_ready(const Unit&) const {}
    __device__ __forceinline__ void done(const Unit&) const {}
};

__device__ __forceinline__ unsigned cvt_pk_bf16(float lo, float hi) { unsigned r; asm volatile("v_cvt_pk_bf16_f32 %0, %1, %2" : "=v"(r) : "v"(lo), "v"(hi)); return r; }
template <class Epi, class Sched, bool ALIGN_EPI = false, bool SP2 = false>
__device__ __forceinline__ void gemm_phase(PG8_LAS unsigned char* lds, const Gemm g, const Sched& S, const Epi& E) {
    int tid_ = threadIdx.x; asm volatile("" : "+v"(tid_));
    const int tid = tid_, wid = __builtin_amdgcn_readfirstlane(tid >> 6), lane = tid & 63, wr = wid >> 2, wc = wid & 3, fr = lane & 15, fq = lane >> 4;
    const int K = g.K, nt = K / BK;
    unsigned voffA[2], voffB[2];
#pragma unroll
    for (int i = 0; i < 2; ++i) { int R, C; stage_rc(tid * 16 + i * 8192, R, C); const int Rb = Epi::PERM ? ((R & ~31) + perm32(R & 31)) : R;
        voffA[i] = (unsigned)(R * K + C) * 2u; voffB[i] = (unsigned)(Rb * K + C) * 2u; }
    const size_t kstep = (size_t)(BK * 2);
    const size_t hstep = (size_t)HALF * K * 2;
    const size_t tstep = 2 * hstep;
    const unsigned ldsw = (unsigned)wid * 1024u;
    const int aoff = lds_byte(wr * 64 + fr, fq * 8), boff = lds_byte(wc * 32 + fr, fq * 8);
#define PG8_SA(b, h) (((b) * 2 + (h)) * HTB)
#define PG8_SB(b, h) ((4 + (b) * 2 + (h)) * HTB)
#define PG8_STAGE(bufoff, gbase, voff) do { _Pragma("unroll") for (int _i = 0; _i < 2; ++_i) \
        __builtin_amdgcn_global_load_lds((const unsigned*)((const char*)(gbase) + (voff)[_i]), (PG8_LAS unsigned*)(lds + (bufoff) + ldsw + _i * 8192), 16, 0, 0); } while (0)
#define PG8_LDA(dst, b, h) do { _Pragma("unroll") for (int m = 0; m < 4; ++m) _Pragma("unroll") for (int k = 0; k < 2; ++k) dst[m][k] = *(const PG8_LAS bf16x8*)(lds + PG8_SA(b, h) + aoff + m * 2048 + k * 1024); } while (0)
#define PG8_LDB(dst, b, h) do { _Pragma("unroll") for (int n = 0; n < 2; ++n) _Pragma("unroll") for (int k = 0; k < 2; ++k) dst[n][k] = *(const PG8_LAS bf16x8*)(lds + PG8_SB(b, h) + boff + n * 2048 + k * 1024); } while (0)
#define PG8_MMA(ai, bj, At, Bt) do { __builtin_amdgcn_s_setprio(1); _Pragma("unroll") for (int m = 0; m < 4; ++m) _Pragma("unroll") for (int n = 0; n < 2; ++n) _Pragma("unroll") for (int k = 0; k < 2; ++k) \
        acc[ai][bj][m][n] = __builtin_amdgcn_mfma_f32_16x16x32_bf16(Bt[n][k], At[m][k], acc[ai][bj][m][n], 0, 0, 0); __builtin_amdgcn_s_setprio(0); } while (0)
#define PG8_WAIT_V(n) asm volatile("s_waitcnt vmcnt(" #n ")" ::: "memory")
#define PG8_WAIT_L(n) asm volatile("s_waitcnt lgkmcnt(" #n ")" ::: "memory")
#define PG8_BAR __builtin_amdgcn_s_barrier()
#define PG8_SCHED __builtin_amdgcn_sched_barrier(0)
    Unit cur, nxt; int ui = 0;
    if (!S.next(0, cur)) return;
    f32x4 acc[2][2][4][2];
#pragma unroll
    for (int a = 0; a < 2; ++a)
#pragma unroll
        for (int b = 0; b < 2; ++b)
#pragma unroll
            for (int m = 0; m < 4; ++m)
#pragma unroll
                for (int n = 0; n < 2; ++n) acc[a][b][m][n] = (f32x4){0.f, 0.f, 0.f, 0.f};
    bf16x8 At[4][2], B0[2][2], B1[2][2];
    const char* cA = (const char*)g.A + (size_t)cur.pm * tstep; const char* cB = (const char*)g.Bt + (size_t)cur.pn * tstep;
    S.a_ready(cur);
    if constexpr (SP2) {
        PG8_STAGE(PG8_SB(0, 0), cB, voffB); PG8_STAGE(PG8_SB(0, 1), cB + hstep, voffB); PG8_STAGE(PG8_SA(0, 0), cA, voffA); PG8_STAGE(PG8_SA(0, 1), cA + hstep, voffA);
        if (wr == 1) PG8_BAR;
        PG8_WAIT_V(2); PG8_BAR;
        PG8_STAGE(PG8_SB(1, 0), cB + kstep, voffB); PG8_STAGE(PG8_SA(1, 0), cA + kstep, voffA); PG8_STAGE(PG8_SB(1, 1), cB + hstep + kstep, voffB);
        PG8_WAIT_V(6); PG8_BAR;
    } else {
        PG8_STAGE(PG8_SB(0, 0), cB, voffB); PG8_STAGE(PG8_SA(0, 0), cA, voffA); PG8_STAGE(PG8_SB(0, 1), cB + hstep, voffB); PG8_STAGE(PG8_SA(0, 1), cA + hstep, voffA);
        if (wr == 1) PG8_BAR;
        PG8_WAIT_V(4); PG8_BAR;
        PG8_STAGE(PG8_SB(1, 0), cB + kstep, voffB); PG8_STAGE(PG8_SA(1, 0), cA + kstep, voffA); PG8_STAGE(PG8_SB(1, 1), cB + hstep + kstep, voffB);
        PG8_WAIT_V(6); PG8_BAR;
    }
    for (;;) {
        const bool has_next = S.next(ui + 1, nxt);
        const char* nA = has_next ? (const char*)g.A + (size_t)nxt.pm * tstep : cA; const char* nB = has_next ? (const char*)g.Bt + (size_t)nxt.pn * tstep : cB;
        for (int t = 0; t < nt; t += 2) {
            const bool last = (t == nt - 2);
            const char* a1 = cA + (size_t)(t + 1) * kstep;
            const char* a2 = last ? nA : cA + (size_t)(t + 2) * kstep; const char* b2 = last ? nB : cB + (size_t)(t + 2) * kstep;
            const char* a3 = a2 + kstep; const char* b3 = b2 + kstep;
            if (last && has_next) S.a_ready(nxt);
            if constexpr (SP2) {
            PG8_LDB(B0, 0, 0); PG8_LDB(B1, 0, 1); PG8_SCHED; PG8_LDA(At, 0, 0); PG8_STAGE(PG8_SA(1, 1), a1 + hstep, voffA);
            PG8_WAIT_V(8); PG8_WAIT_L(0); PG8_BAR; PG8_MMA(0, 0, At, B0); PG8_MMA(0, 1, At, B1); PG8_BAR; PG8_SCHED;
            PG8_LDA(At, 0, 1); PG8_STAGE(PG8_SB(0, 0), b2, voffB); PG8_STAGE(PG8_SB(0, 1), b2 + hstep, voffB); PG8_STAGE(PG8_SA(0, 0), a2, voffA);
            PG8_WAIT_V(8); PG8_WAIT_L(0); PG8_BAR; PG8_MMA(1, 0, At, B0); PG8_MMA(1, 1, At, B1); PG8_BAR; PG8_SCHED;
            PG8_LDB(B0, 1, 0); PG8_LDB(B1, 1, 1); PG8_SCHED; PG8_LDA(At, 1, 0); PG8_STAGE(PG8_SA(0, 1), a2 + hstep, voffA);
            PG8_WAIT_V(8); PG8_WAIT_L(0); PG8_BAR; PG8_MMA(0, 0, At, B0); PG8_MMA(0, 1, At, B1); PG8_BAR; PG8_SCHED;
            PG8_LDA(At, 1, 1); PG8_STAGE(PG8_SB(1, 0), b3, voffB); PG8_STAGE(PG8_SB(1, 1), b3 + hstep, voffB); PG8_STAGE(PG8_SA(1, 0), a3, voffA);
            PG8_WAIT_V(8); PG8_WAIT_L(0); PG8_BAR; PG8_MMA(1, 0, At, B0); PG8_MMA(1, 1, At, B1); PG8_BAR; PG8_SCHED;
            } else {
            PG8_LDB(B0, 0, 0); PG8_SCHED; PG8_LDA(At, 0, 0); PG8_STAGE(PG8_SA(1, 1), a1 + hstep, voffA);
            PG8_WAIT_L(8); PG8_BAR; PG8_WAIT_L(0); PG8_MMA(0, 0, At, B0); PG8_BAR; PG8_SCHED;
            PG8_LDB(B1, 0, 1); PG8_STAGE(PG8_SB(0, 0), b2, voffB);
            PG8_BAR; PG8_WAIT_L(0); PG8_MMA(0, 1, At, B1); PG8_BAR;
            PG8_LDA(At, 0, 1); PG8_STAGE(PG8_SA(0, 0), a2, voffA);
            PG8_BAR; PG8_WAIT_L(0); PG8_MMA(1, 0, At, B0); PG8_BAR; PG8_SCHED;
            PG8_STAGE(PG8_SB(0, 1), b2 + hstep, voffB);
            PG8_WAIT_V(6); PG8_BAR; PG8_MMA(1, 1, At, B1); PG8_BAR;
            PG8_LDB(B0, 1, 0); PG8_SCHED; PG8_LDA(At, 1, 0); PG8_STAGE(PG8_SA(0, 1), a2 + hstep, voffA);
            PG8_WAIT_L(8); PG8_BAR; PG8_WAIT_L(0); PG8_MMA(0, 0, At, B0); PG8_BAR; PG8_SCHED;
            PG8_LDB(B1, 1, 1); PG8_STAGE(PG8_SB(1, 0), b3, voffB);
            PG8_BAR; PG8_WAIT_L(0); PG8_MMA(0, 1, At, B1); PG8_BAR;
            PG8_LDA(At, 1, 1); PG8_STAGE(PG8_SA(1, 0), a3, voffA);
            PG8_BAR; PG8_WAIT_L(0); PG8_MMA(1, 0, At, B0); PG8_BAR; PG8_SCHED;
            PG8_STAGE(PG8_SB(1, 1), b3 + hstep, voffB);
            PG8_WAIT_V(6); PG8_BAR; PG8_MMA(1, 1, At, B1); PG8_BAR;
            }
        }
        if constexpr (ALIGN_EPI) { if (wr == 0) PG8_BAR; }
        if constexpr (!Epi::AFTER_DRAIN) { E(acc, cur, wr, wc, fr, fq); S.done(cur); }
        if (!has_next) break;
#pragma unroll
        for (int a = 0; a < 2; ++a)
#pragma unroll
            for (int b = 0; b < 2; ++b)
#pragma unroll
                for (int m = 0; m < 4; ++m)
#pragma unroll
                    for (int n = 0; n < 2; ++n) acc[a][b][m][n] = (f32x4){0.f, 0.f, 0.f, 0.f};
        cur = nxt; cA = nA; cB = nB; ++ui;
        if constexpr (ALIGN_EPI) { if (wr == 1) PG8_BAR; }
    }
    PG8_WAIT_V(0);
    if constexpr (!ALIGN_EPI) { if (wr == 0) PG8_BAR; }
    PG8_BAR;
    if constexpr (Epi::AFTER_DRAIN) { E.fused(acc, cur, wr, wc, fr, fq, lds, wid, lane); S.done(cur); }
#undef PG8_SA
#undef PG8_SB
#undef PG8_STAGE
#undef PG8_LDA
#undef PG8_LDB
#undef PG8_MMA
#undef PG8_WAIT_V
#undef PG8_WAIT_L
#undef PG8_BAR
#undef PG8_SCHED
}
}

#define LAS __attribute__((address_space(3)))
typedef unsigned short bf16;
typedef unsigned v4u __attribute__((ext_vector_type(4)));
typedef unsigned v2u __attribute__((ext_vector_type(2)));
typedef float f32x4 __attribute__((ext_vector_type(4)));
typedef short bf16x8 __attribute__((ext_vector_type(8)));

constexpr int NB = 32, SEQ = 2048, DM = 1024, MTOK = NB * SEQ, DIN = 4232, NPJ = 4352;
constexpr int PU = 0, PV = 256, PZ = 512, PMQ = 768, PMK = 1152, PMV = 1536, PMO = 1920, PMZ = 2304, PSQ = 2688, PSK = 3072, PSV = 3456, PSZ = 3840, PGI = 4224;
constexpr float EPSN = 1e-6f, LOG2E = 1.4426950408889634f;
constexpr size_t MiB = 1u << 20;
constexpr size_t WS_CTL = 0, WS_MOD = 1 * MiB, WS_GATE = 2 * MiB, WS_WIN = 4 * MiB, WS_WOUT = 22 * MiB, WS_H = 32 * MiB, WS_PROJ = 160 * MiB, WS_HALO = 704 * MiB, WS_END = 712 * MiB;
constexpr size_t WIN_ELEMS = (size_t)NPJ * DM, WOUT_ELEMS = (size_t)DM * DM;
constexpr int LDS_BYTES = 147456;
constexpr int NPHASE = 9;
constexpr int N_ML = 128, N_AT = NB * 6 * 16, N_GM = NB * 4 * 4, N_UNITS = N_ML + N_AT + N_GM;

__device__ __forceinline__ unsigned pk2(float lo, float hi) { unsigned r; asm("v_cvt_pk_bf16_f32 %0, %1, %2" : "=v"(r) : "v"(lo), "v"(hi)); return r; }
__device__ __forceinline__ float blo(unsigned w) { return __uint_as_float(w << 16); }
__device__ __forceinline__ float bhi(unsigned w) { return __uint_as_float(w & 0xffff0000u); }
__device__ __forceinline__ float fexp2(float x) { return __builtin_amdgcn_exp2f(x); }
__device__ __forceinline__ float fexp(float x) { return __builtin_amdgcn_exp2f(x * LOG2E); }
__device__ __forceinline__ float frcp(float x) { return __builtin_amdgcn_rcpf(x); }
__device__ __forceinline__ float sigmoidf_(float x) { return frcp(1.0f + fexp2(-x * LOG2E)); }
__device__ __forceinline__ float siluf_(float x) { return x * sigmoidf_(x); }
__device__ __forceinline__ float geluf_(float x) { const float y = 1.5957691216057308f * (x + 0.044715f * x * x * x); return x * sigmoidf_(y); }
__device__ __forceinline__ float logsigf_(float x) { return fminf(x, 0.f) - 0.6931471805599453f * __builtin_amdgcn_logf(1.0f + fexp2(-fabsf(x) * LOG2E)); }
__device__ __forceinline__ f32x4 mfma16(bf16x8 a, bf16x8 b, f32x4 c) { return __builtin_amdgcn_mfma_f32_16x16x32_bf16(a, b, c, 0, 0, 0); }
__device__ __forceinline__ bf16x8 mk8(unsigned a, unsigned b, unsigned c, unsigned d) { v4u w; w.x = a; w.y = b; w.z = c; w.w = d; return __builtin_bit_cast(bf16x8, w); }
#define LBAR() do { asm volatile("s_waitcnt lgkmcnt(0)" ::: "memory"); __builtin_amdgcn_s_barrier(); asm volatile("" ::: "memory"); } while (0)
__device__ __forceinline__ float wave_sum(float v) {
#pragma unroll
    for (int o = 1; o < 64; o <<= 1) v += __shfl_xor(v, o);
    return v;
}

__device__ __forceinline__ float actf(float x, int act) {
    const float y = act == 1 ? 1.5957691216057308f * (x + 0.044715f * x * x * x) : x;
    const float sg = sigmoidf_(y);
    return act == 3 ? sg : x * sg;
}
template <int K> __device__ __forceinline__ float row_prev(float xm, float xm1) {
    const int o = __builtin_amdgcn_update_dpp(0, __float_as_int(xm1), 0x120 + K, 0xf, 0xf, false);
    return __int_as_float(__builtin_amdgcn_update_dpp(o, __float_as_int(xm), 0x110 + K, 0xf, 0xf, false));
}
struct EpiProj {
    static constexpr bool PERM = true, AFTER_DRAIN = false;
    bf16* O; float* gate; const float* convw; const float* convb; bf16* halo;
    __device__ __forceinline__ void operator()(const f32x4 (&acc)[2][2][4][2], const pg8::Unit& u, int wr, int wc, int fr, int fq) const {
        const int row0 = u.pm * 256 + wr * 64 + fr, col0 = u.pn * 256 + wc * 32 + 8 * fq;
        if (u.pn >= 3 && u.pn <= 5) {
#pragma unroll
            for (int bj = 0; bj < 2; ++bj) {
                const int ch0 = u.pn * 256 + bj * 128 - 768 + wc * 32 + 8 * fq;
                const float sc = ch0 >= 384 ? 0.10206207261596575f : 1.0f;
                float wv[4][8], bv[8];
#pragma unroll
                for (int tap = 0; tap < 4; ++tap) { const f32x4 a = *(const f32x4*)(convw + tap * 768 + ch0), b2 = *(const f32x4*)(convw + tap * 768 + ch0 + 4);
#pragma unroll
                    for (int i = 0; i < 4; ++i) { wv[tap][i] = a[i]; wv[tap][4 + i] = b2[i]; } }
                { const f32x4 a = *(const f32x4*)(convb + ch0), b2 = *(const f32x4*)(convb + ch0 + 4);
#pragma unroll
                  for (int i = 0; i < 4; ++i) { bv[i] = a[i]; bv[4 + i] = b2[i]; } }
#pragma unroll
                for (int ai = 0; ai < 2; ++ai) {
#pragma unroll
                    for (int m = 0; m < 4; ++m) {
                        float o[8];
#pragma unroll
                        for (int i = 0; i < 8; ++i) {
                            const float x0 = acc[ai][bj][m][i >> 2][i & 3];
                            const float xm1 = m > 0 ? acc[ai][bj][m > 0 ? m - 1 : 0][i >> 2][i & 3] : 0.f;
                            const float p1 = row_prev<1>(x0, xm1), p2 = row_prev<2>(x0, xm1), p3 = row_prev<3>(x0, xm1);
                            float y = bv[i];
                            y = __builtin_fmaf(wv[0][i], p3, y); y = __builtin_fmaf(wv[1][i], p2, y); y = __builtin_fmaf(wv[2][i], p1, y); y = __builtin_fmaf(wv[3][i], x0, y);
                            y = siluf_(y) * sc;
                            if (m == 0 && fr < 3) y = x0;
                            o[i] = y;
                        }
                        v4u w; w.x = pk2(o[0], o[1]); w.y = pk2(o[2], o[3]); w.z = pk2(o[4], o[5]); w.w = pk2(o[6], o[7]);
                        *(v4u*)(O + (size_t)(row0 + ai * 128 + m * 16) * NPJ + col0 + bj * 128) = w;
                        if (m == 3 && fr >= 13) {
                            const f32x4 v0 = acc[ai][bj][3][0], v1 = acc[ai][bj][3][1];
                            v4u hw; hw.x = pk2(v0[0], v0[1]); hw.y = pk2(v0[2], v0[3]); hw.z = pk2(v1[0], v1[1]); hw.w = pk2(v1[2], v1[3]);
                            *(v4u*)(halo + ((size_t)((4 * u.pm + 2 * ai + wr) * 3 + (fr - 13))) * 768 + ch0) = hw;
                        }
                    }
                }
            }
            return;
        }
        const unsigned long long SILU_M = (0x7ull << 18), SIGM_M = 0x7ull << 15;
        const int sg0 = 2 * u.pn, sg1 = sg0 + 1;
        const int act0 = ((SILU_M >> sg0) & 1) ? 2 : (((SIGM_M >> sg0) & 1) ? 3 : 0);
        const int act1 = ((SILU_M >> sg1) & 1) ? 2 : (((SIGM_M >> sg1) & 1) ? 3 : 0);
#pragma unroll
        for (int ai = 0; ai < 2; ++ai)
#pragma unroll
            for (int m = 0; m < 4; ++m) {
                bf16* rowp = O + (size_t)(row0 + ai * 128 + m * 16) * NPJ + col0;
#pragma unroll
                for (int bj = 0; bj < 2; ++bj) {
                    f32x4 v0 = acc[ai][bj][m][0], v1 = acc[ai][bj][m][1];
                    const int act = bj ? act1 : act0;
                    if (act) {
#pragma unroll
                        for (int i = 0; i < 4; ++i) { v0[i] = actf(v0[i], act); v1[i] = actf(v1[i], act); }
                    }
                    v4u w; w.x = pk2(v0[0], v0[1]); w.y = pk2(v0[2], v0[3]); w.z = pk2(v1[0], v1[1]); w.w = pk2(v1[2], v1[3]);
                    *(v4u*)(rowp + bj * 128) = w;
                }
            }
        if (u.pn == 16 && wc == 0 && fq == 0) {
#pragma unroll
            for (int ai = 0; ai < 2; ++ai)
#pragma unroll
                for (int m = 0; m < 4; ++m) {
                    float* g = gate + (size_t)(row0 + ai * 128 + m * 16) * 8;
                    *(f32x4*)g = acc[ai][1][m][0]; *(f32x4*)(g + 4) = acc[ai][1][m][1];
                }
        }
    }
};
struct EpiOut {
    static constexpr bool PERM = false, AFTER_DRAIN = false;
    const float* xin; float* out; const float* gatev;
    __device__ __forceinline__ void operator()(const f32x4 (&acc)[2][2][4][2], const pg8::Unit& u, int wr, int wc, int fr, int fq) const {
        const int row0 = u.pm * 256 + wr * 64 + fr, col0 = u.pn * 256 + wc * 32 + 4 * fq;
        const float* gp = gatev + (size_t)(u.pm >> 3) * 3072 + col0;
        f32x4 gv[2][2];
#pragma unroll
        for (int bj = 0; bj < 2; ++bj)
#pragma unroll
            for (int n = 0; n < 2; ++n) gv[bj][n] = *(const f32x4*)(gp + bj * 128 + n * 16);
#pragma unroll
        for (int ai = 0; ai < 2; ++ai)
#pragma unroll
            for (int m = 0; m < 4; ++m) {
                const size_t off = (size_t)(row0 + ai * 128 + m * 16) * DM + col0;
#pragma unroll
                for (int bj = 0; bj < 2; ++bj)
#pragma unroll
                    for (int n = 0; n < 2; ++n) {
                        const f32x4 xv = *(const f32x4*)(xin + off + bj * 128 + n * 16);
                        *(f32x4*)(out + off + bj * 128 + n * 16) = xv + gv[bj][n] * acc[ai][bj][m][n];
                    }
                asm volatile("" ::: "memory");
            }
    }
};

template <bool WIN>
__device__ __forceinline__ void p0_transpose_item(const float* W, int srcN, bf16* WT, LAS float* scr, int item, int nblk, int lane) {
    const int kb = item / nblk, nb = item % nblk, k0 = 64 * kb, n0 = 32 * nb;
    const int nd = n0 + (lane & 31);
    int sc = nd;
    if (WIN) { sc = nd < PSQ ? nd : (nd < PGI ? nd + 8 : (nd < DIN ? nd - PGI + 2688 : -1)); }
#pragma unroll 8
    for (int i = 0; i < 32; ++i) { const int kk = 2 * i + (lane >> 5); scr[kk * 33 + (lane & 31)] = sc >= 0 ? W[(size_t)(k0 + kk) * srcN + sc] : 0.f; }
    asm volatile("s_waitcnt lgkmcnt(0)" ::: "memory");
    const int c = lane & 7;
#pragma unroll
    for (int j = 0; j < 4; ++j) { const int n = (lane >> 3) + 8 * j; const LAS float* s = scr + (8 * c) * 33 + n;
        v4u o; o.x = pk2(s[0 * 33], s[1 * 33]); o.y = pk2(s[2 * 33], s[3 * 33]); o.z = pk2(s[4 * 33], s[5 * 33]); o.w = pk2(s[6 * 33], s[7 * 33]);
        *(v4u*)(WT + (size_t)(n0 + n) * DM + k0 + 8 * c) = o; }
    asm volatile("s_waitcnt lgkmcnt(0)" ::: "memory");
}

__device__ __forceinline__ void p0_phase(LAS unsigned char* lds, const float* c, const float* w_ada, const float* b_ada, const float* w_in, const float* w_out,
                                         float* mod, bf16* win_t, bf16* wout_t, int tid, int wid, int lane) {
    LAS float* cs = (LAS float*)lds;
    for (int unit = blockIdx.x; unit < 96; unit += gridDim.x) {
        const int l = unit / 48, nb = unit % 48;
        __syncthreads();
        for (int i = tid; i < 32 * 1024; i += 512) { const float cv = c[i]; cs[i] = siluf_(cv); }
        __syncthreads();
        const int n = nb * 64 + lane, kbase = wid * 128;
        const float* wp = w_ada + (size_t)l * 1024 * 3072 + (size_t)kbase * 3072 + n;
        float acc[32];
#pragma unroll
        for (int b = 0; b < 32; ++b) acc[b] = 0.f;
#pragma unroll 2
        for (int k = 0; k < 128; k += 4) {
            const float w0 = wp[(size_t)k * 3072], w1 = wp[(size_t)(k + 1) * 3072], w2 = wp[(size_t)(k + 2) * 3072], w3 = wp[(size_t)(k + 3) * 3072];
#pragma unroll
            for (int b = 0; b < 32; ++b) { const f32x4 cv = *(const LAS f32x4*)(cs + b * 1024 + kbase + k); acc[b] += cv[0] * w0 + cv[1] * w1 + cv[2] * w2 + cv[3] * w3; }
        }
        __syncthreads();
        LAS float* part = (LAS float*)lds;
#pragma unroll
        for (int b = 0; b < 32; ++b) part[(wid * 32 + b) * 64 + lane] = acc[b];
        __syncthreads();
        {
            const int nn = tid & 63, bg = tid >> 6;
#pragma unroll
            for (int bb = 0; bb < 4; ++bb) { const int b = bg * 4 + bb; float s = 0.f;
#pragma unroll
                for (int w = 0; w < 8; ++w) s += part[(w * 32 + b) * 64 + nn];
                mod[((size_t)l * 32 + b) * 3072 + nb * 64 + nn] = s + b_ada[l * 3072 + nb * 64 + nn]; }
        }
    }
    __syncthreads();
    LAS float* scr = (LAS float*)(lds + wid * 16384);
    int gw = blockIdx.x * 8 + wid, NGW = gridDim.x * 8;
    if (gridDim.x >= 192) { if (blockIdx.x < 96) return; gw -= 96 * 8; NGW -= 96 * 8; }
    constexpr int I_IN = 16 * (NPJ / 32), I_OUT = 16 * (DM / 32);
    for (int it = gw; it < 2 * (I_IN + I_OUT); it += NGW) {
        int r = it;
        if (r < 2 * I_IN) { const int l = r / I_IN; r -= l * I_IN; p0_transpose_item<true>(w_in + (size_t)l * DM * DIN, DIN, win_t + (size_t)l * WIN_ELEMS, scr, r, NPJ / 32, lane); }
        else { r -= 2 * I_IN; const int l = r / I_OUT; r -= l * I_OUT; p0_transpose_item<false>(w_out + (size_t)l * WOUT_ELEMS, DM, wout_t + (size_t)l * WOUT_ELEMS, scr, r, DM / 32, lane); }
    }
}

__device__ __forceinline__ void p1_phase(const float* xin, const float* g, const float* modl, bf16* H, int wid, int lane) {
    const int gw = blockIdx.x * 8 + wid, NGW = gridDim.x * 8;
    for (int base = gw * 32; base < MTOK; base += NGW * 32) {
        const int b = base >> 11;
        f32x4 gs[4], sh[4];
#pragma unroll
        for (int j = 0; j < 4; ++j) { const int k = 4 * lane + 256 * j;
            const f32x4 gg = *(const f32x4*)(g + k), sc = *(const f32x4*)(modl + (size_t)b * 3072 + 1024 + k);
            gs[j] = gg * (sc + 1.0f); sh[j] = *(const f32x4*)(modl + (size_t)b * 3072 + k); }
        for (int r = 0; r < 32; ++r) {
            const float* xr = xin + (size_t)(base + r) * DM + 4 * lane;
            f32x4 v[4]; float s = 0.f;
#pragma unroll
            for (int j = 0; j < 4; ++j) { v[j] = *(const f32x4*)(xr + 256 * j); s += (v[j][0] * v[j][0] + v[j][1] * v[j][1]) + (v[j][2] * v[j][2] + v[j][3] * v[j][3]); }
            const float rs = __builtin_amdgcn_rsqf(wave_sum(s) * (1.0f / DM) + EPSN);
            bf16* orow = H + (size_t)(base + r) * DM + 4 * lane;
#pragma unroll
            for (int j = 0; j < 4; ++j) { const f32x4 o = v[j] * rs * gs[j] + sh[j]; v2u w; w.x = pk2(o[0], o[1]); w.y = pk2(o[2], o[3]); *(v2u*)(orow + 256 * j) = w; }
        }
    }
}

struct AtPre { v4u k[2], v[2], q[2]; };
__device__ __forceinline__ void attn_unit(LAS unsigned char* lds, const bf16* P, bf16* Y, const float* gq, const float* gk, int b, int h, int qb, int tid, int wid, int lane,
                                          const bool have, AtPre& pf, const bool nvalid, const int nb, const int nh, const int nqb) {
    LAS bf16* Ks = (LAS bf16*)lds;
    LAS bf16* Vt = (LAS bf16*)(lds + 18432);
    volatile LAS int* flags = (volatile LAS int*)(lds + 35840);
    const int tq = lane & 15, quad = lane >> 4;
    const size_t row0 = (size_t)b * SEQ;
    const int t0 = qb * 128, t = t0 + 16 * wid + tq;
    const int sr = tid >> 3, dc = tid & 7, srv = tid & 127, dcv = tid >> 7;
    const bf16* kbase = P + (row0 + sr) * NPJ + PSK + h * 64 + 8 * dc;
    const bf16* vbase = P + (row0 + srv) * NPJ + PSV + h * 64 + 8 * dcv;
    v4u kwn[2], vwn[2], q0, q1;
    if (have) { kwn[0] = pf.k[0]; kwn[1] = pf.k[1]; vwn[0] = pf.v[0]; vwn[1] = pf.v[1]; q0 = pf.q[0]; q1 = pf.q[1]; }
    else {
        const size_t adv = (size_t)(128 * qb) * NPJ;
        kwn[0] = *(const v4u*)(kbase + adv); kwn[1] = *(const v4u*)(kbase + adv + (size_t)64 * NPJ);
        vwn[0] = *(const v4u*)(vbase + adv); vwn[1] = *(const v4u*)(vbase + adv + 32);
        const bf16* qp = P + (row0 + t) * NPJ + PSQ + h * 64;
        q0 = *(const v4u*)(qp + 8 * quad); q1 = *(const v4u*)(qp + 32 + 8 * quad);
    }
    bf16x8 Bq0, Bq1;
    {
        float qf[16];
#pragma unroll
        for (int i = 0; i < 4; ++i) { qf[2 * i] = blo(q0[i]); qf[2 * i + 1] = bhi(q0[i]); qf[8 + 2 * i] = blo(q1[i]); qf[9 + 2 * i] = bhi(q1[i]); }
        float ss = 0.f;
#pragma unroll
        for (int i = 0; i < 16; ++i) ss += qf[i] * qf[i];
        ss += __shfl_xor(ss, 16); ss += __shfl_xor(ss, 32);
        const float rs = __builtin_amdgcn_rsqf(ss * (1.0f / 64.0f) + EPSN) * (0.125f * LOG2E);
        const f32x4 g0 = *(const f32x4*)(gq + 8 * quad), g1 = *(const f32x4*)(gq + 8 * quad + 4), g2 = *(const f32x4*)(gq + 32 + 8 * quad), g3 = *(const f32x4*)(gq + 36 + 8 * quad);
#pragma unroll
        for (int i = 0; i < 4; ++i) { qf[i] *= rs * g0[i]; qf[4 + i] *= rs * g1[i]; qf[8 + i] *= rs * g2[i]; qf[12 + i] *= rs * g3[i]; }
        Bq0 = mk8(pk2(qf[0], qf[1]), pk2(qf[2], qf[3]), pk2(qf[4], qf[5]), pk2(qf[6], qf[7]));
        Bq1 = mk8(pk2(qf[8], qf[9]), pk2(qf[10], qf[11]), pk2(qf[12], qf[13]), pk2(qf[14], qf[15]));
    }
    v2u zwp[4];
    {
        const bf16* zp = P + (row0 + t) * NPJ + PSZ + h * 64 + 4 * quad;
#pragma unroll
        for (int dt = 0; dt < 4; ++dt) zwp[dt] = *(const v2u*)(zp + 16 * dt);
    }
    f32x4 O[4];
#pragma unroll
    for (int i = 0; i < 4; ++i) O[i] = (f32x4){0.f, 0.f, 0.f, 0.f};
    float R = 1.0f;
    bool wdone = false;
    if (tid < 3) flags[tid] = 0;
    const int tg = 8 * qb + wid;
    const f32x4 gk0 = *(const f32x4*)(gk + 8 * dc), gk1 = *(const f32x4*)(gk + 8 * dc + 4);
    int it = 0;
    for (int kt = qb; kt >= 0; --kt, ++it) {
        {
            v4u kw[2], vw[2];
            kw[0] = kwn[0]; kw[1] = kwn[1]; vw[0] = vwn[0]; vw[1] = vwn[1];
            if (kt > 0) {
                const size_t adv = (size_t)(128 * (kt - 1)) * NPJ;
                kwn[0] = *(const v4u*)(kbase + adv); kwn[1] = *(const v4u*)(kbase + adv + (size_t)64 * NPJ);
                vwn[0] = *(const v4u*)(vbase + adv); vwn[1] = *(const v4u*)(vbase + adv + 32);
            }
#pragma unroll
            for (int hf = 0; hf < 2; ++hf) {
                float kf[8];
#pragma unroll
                for (int i = 0; i < 4; ++i) { kf[2 * i] = blo(kw[hf][i]); kf[2 * i + 1] = bhi(kw[hf][i]); }
                float ss = 0.f;
#pragma unroll
                for (int i = 0; i < 8; ++i) ss += kf[i] * kf[i];
                ss += __shfl_xor(ss, 1); ss += __shfl_xor(ss, 2); ss += __shfl_xor(ss, 4);
                const float rs = __builtin_amdgcn_rsqf(ss * (1.0f / 64.0f) + EPSN);
#pragma unroll
                for (int i = 0; i < 4; ++i) { kf[i] *= rs * gk0[i]; kf[4 + i] *= rs * gk1[i]; }
                v4u o; o.x = pk2(kf[0], kf[1]); o.y = pk2(kf[2], kf[3]); o.z = pk2(kf[4], kf[5]); o.w = pk2(kf[6], kf[7]);
                *(LAS v4u*)(Ks + (sr + 64 * hf) * 72 + 8 * dc) = o;
#pragma unroll
                for (int i = 0; i < 4; ++i) { Vt[(8 * (dcv + 4 * hf) + 2 * i) * 136 + srv] = (bf16)(vw[hf][i] & 0xffffu); Vt[(8 * (dcv + 4 * hf) + 2 * i + 1) * 136 + srv] = (bf16)(vw[hf][i] >> 16); }
            }
        }
        if (tid == 0) flags[(it + 1) % 3] = 0;
        LBAR();
        if (!wdone) {
#pragma unroll
            for (int p = 3; p >= 0; --p) {
                if (8 * kt + 2 * p <= tg && !wdone) {
                    float av[2][4];
#pragma unroll
                    for (int u = 1; u >= 0; --u) {
                        const int st = 2 * p + u, sg = 8 * kt + st;
                        if (sg > tg) {
#pragma unroll
                            for (int j = 0; j < 4; ++j) av[u][j] = 0.f;
                        } else {
                            const bf16x8 a0 = *(const LAS bf16x8*)(Ks + (16 * st + tq) * 72 + 8 * quad), a1 = *(const LAS bf16x8*)(Ks + (16 * st + tq) * 72 + 32 + 8 * quad);
                            f32x4 z = (f32x4){0.f, 0.f, 0.f, 0.f};
                            z = mfma16(a0, Bq0, z); z = mfma16(a1, Bq1, z);
                            float r[4], be[4];
#pragma unroll
                            for (int j = 0; j < 4; ++j) { const float e = fexp2(fminf(z[j], 80.f)); const float rr = frcp(1.0f + e); r[j] = rr; be[j] = e * rr; }
                            if (sg == tg) {
                                int tql = tq; asm volatile("" : "+v"(tql));
#pragma unroll
                                for (int j = 0; j < 4; ++j) if (4 * quad + j >= tql) { r[j] = 1.0f; be[j] = 0.f; }
                            }
                            const float x2 = r[3], x1 = x2 * r[2], x0 = x1 * r[1], T = x0 * r[0];
                            const float A_ = __shfl_xor(T, 16), Bp = T * A_, Cc = __shfl_xor(Bp, 32);
                            const float Xq = quad == 3 ? 1.0f : (quad == 2 ? A_ : (quad == 1 ? Cc : A_ * Cc));
                            const float Yv = Xq * R;
                            av[u][3] = be[3] * Yv; av[u][2] = be[2] * (x2 * Yv); av[u][1] = be[1] * (x1 * Yv); av[u][0] = be[0] * (x0 * Yv);
                            R *= Bp * Cc;
                        }
                    }
                    const bf16x8 Bf = mk8(pk2(av[0][0], av[0][1]), pk2(av[0][2], av[0][3]), pk2(av[1][0], av[1][1]), pk2(av[1][2], av[1][3]));
#pragma unroll
                    for (int dt = 0; dt < 4; ++dt) {
                        const v2u lo = *(const LAS v2u*)(Vt + (16 * dt + tq) * 136 + 32 * p + 4 * quad), hi = *(const LAS v2u*)(Vt + (16 * dt + tq) * 136 + 32 * p + 16 + 4 * quad);
                        O[dt] = mfma16(mk8(lo.x, lo.y, hi.x, hi.y), Bf, O[dt]);
                    }
                    if (__ballot(R >= 1e-20f) == 0ull) wdone = true;
                }
            }
            if (!wdone && lane == 0) flags[it % 3] = 1;
        }
        if (it == 0 && nvalid) {
            const size_t nrow0 = (size_t)nb * SEQ, nadv = (size_t)(128 * nqb) * NPJ;
            const bf16* nk = P + (nrow0 + sr) * NPJ + PSK + nh * 64 + 8 * dc + nadv;
            const bf16* nv = P + (nrow0 + srv) * NPJ + PSV + nh * 64 + 8 * dcv + nadv;
            pf.k[0] = *(const v4u*)nk; pf.k[1] = *(const v4u*)(nk + (size_t)64 * NPJ);
            pf.v[0] = *(const v4u*)nv; pf.v[1] = *(const v4u*)(nv + 32);
            const bf16* nq = P + (nrow0 + 128 * nqb + 16 * wid + tq) * NPJ + PSQ + nh * 64;
            pf.q[0] = *(const v4u*)(nq + 8 * quad); pf.q[1] = *(const v4u*)(nq + 32 + 8 * quad);
        }
        LBAR();
        if (flags[it % 3] == 0) break;
    }
    {
        bf16* yp = Y + (row0 + t) * DM + 640 + h * 64 + 4 * quad;
#pragma unroll
        for (int dt = 0; dt < 4; ++dt) {
            const v2u zw = zwp[dt];
            v2u w; w.x = pk2(O[dt][0] * siluf_(blo(zw.x)), O[dt][1] * siluf_(bhi(zw.x))); w.y = pk2(O[dt][2] * siluf_(blo(zw.y)), O[dt][3] * siluf_(bhi(zw.y)));
            *(v2u*)(yp + 16 * dt) = w;
        }
    }
}

__device__ __forceinline__ void gmlp_unit(LAS unsigned char* lds, const bf16* P, bf16* Y, const float* wsl, const float* bsl, const float* gvl, int b, int cq, int g, int tid, int wid, int lane) {
    LAS bf16* Ws = (LAS bf16*)lds;
    const int tq = lane & 15, quad = lane >> 4;
    {
        int tt = tid >> 2; asm volatile("" : "+v"(tt)); const int sc = (tid & 3) * 32;
        const float* src = wsl + ((size_t)(g * 128 + tt)) * 128 + sc;
#pragma unroll
        for (int q2 = 0; q2 < 4; ++q2) {
            f32x4 f0 = *(const f32x4*)(src + 8 * q2), f1 = *(const f32x4*)(src + 8 * q2 + 4);
#pragma unroll
            for (int i = 0; i < 4; ++i) { if (sc + 8 * q2 + i > tt) f0[i] = 0.f; if (sc + 8 * q2 + 4 + i > tt) f1[i] = 0.f; }
            v4u o; o.x = pk2(f0[0], f0[1]); o.y = pk2(f0[2], f0[3]); o.z = pk2(f1[0], f1[1]); o.w = pk2(f1[2], f1[3]);
            *(LAS v4u*)(Ws + tt * 136 + sc + 8 * q2) = o;
        }
    }
    const int s = tid >> 2, dq = (tid & 3) * 16, tt = 16 * wid + tq;
    const size_t tokb = (size_t)b * SEQ + 512 * cq;
    const bf16* vp = P + (tokb + s) * NPJ + PV + g * 64 + dq;
    const bf16* up = P + (tokb + tt) * NPJ + PU + g * 64 + 4 * quad;
    bf16* yp = Y + (tokb + tt) * DM + g * 64 + 4 * quad;
    const float bs = bsl[g * 128 + tt];
    float gvr[16];
#pragma unroll
    for (int i = 0; i < 4; ++i) { const f32x4 t4 = *(const f32x4*)(gvl + g * 64 + dq + 4 * i); gvr[4 * i] = t4[0]; gvr[4 * i + 1] = t4[1]; gvr[4 * i + 2] = t4[2]; gvr[4 * i + 3] = t4[3]; }
    v4u nv0 = *(const v4u*)vp, nv1 = *(const v4u*)(vp + 8);
    v2u nuw[4], nzw[4];
#pragma unroll
    for (int dt = 0; dt < 4; ++dt) { nuw[dt] = *(const v2u*)(up + 16 * dt); nzw[dt] = *(const v2u*)(up + (PZ - PU) + 16 * dt); }
#pragma unroll 1
    for (int c4 = 0; c4 < 4; ++c4) {
        LAS bf16* Vn = (LAS bf16*)(lds + 34816 + (c4 & 1) * 17408);
        const v4u v0 = nv0, v1 = nv1;
        v2u uw[4], zw[4];
#pragma unroll
        for (int dt = 0; dt < 4; ++dt) { uw[dt] = nuw[dt]; zw[dt] = nzw[dt]; }
        if (c4 < 3) {
            const size_t adv = (size_t)(128 * (c4 + 1)) * NPJ;
            nv0 = *(const v4u*)(vp + adv); nv1 = *(const v4u*)(vp + adv + 8);
#pragma unroll
            for (int dt = 0; dt < 4; ++dt) { nuw[dt] = *(const v2u*)(up + adv + 16 * dt); nzw[dt] = *(const v2u*)(up + adv + (PZ - PU) + 16 * dt); }
        }
        {
            float vf[16];
#pragma unroll
            for (int i = 0; i < 4; ++i) { vf[2 * i] = geluf_(blo(v0[i])); vf[2 * i + 1] = geluf_(bhi(v0[i])); vf[8 + 2 * i] = geluf_(blo(v1[i])); vf[9 + 2 * i] = geluf_(bhi(v1[i])); }
            float ss = 0.f;
#pragma unroll
            for (int i = 0; i < 16; ++i) ss += vf[i] * vf[i];
            ss += __shfl_xor(ss, 1); ss += __shfl_xor(ss, 2);
            const float rs = __builtin_amdgcn_rsqf(ss * (1.0f / 64.0f) + EPSN);
#pragma unroll
            for (int i = 0; i < 16; ++i) { const float o = vf[i] * rs * gvr[i]; Vn[(dq + i) * 136 + s] = (bf16)(pk2(o, 0.f) & 0xffffu); }
        }
        LBAR();
        f32x4 acc[4];
#pragma unroll
        for (int i = 0; i < 4; ++i) acc[i] = (f32x4){0.f, 0.f, 0.f, 0.f};
#pragma unroll
        for (int kk = 0; kk < 4; ++kk) {
            if (kk <= (wid >> 1)) {
                const bf16x8 Bw = *(const LAS bf16x8*)(Ws + tt * 136 + 32 * kk + 8 * quad);
#pragma unroll
                for (int dt = 0; dt < 4; ++dt) { const bf16x8 Av = *(const LAS bf16x8*)(Vn + (16 * dt + tq) * 136 + 32 * kk + 8 * quad); acc[dt] = mfma16(Av, Bw, acc[dt]); }
            }
        }
        bf16* ypc = yp + (size_t)(128 * c4) * DM;
#pragma unroll
        for (int dt = 0; dt < 4; ++dt) {
            const float y0 = geluf_(blo(uw[dt].x)) * (acc[dt][0] + bs) * siluf_(blo(zw[dt].x)), y1 = geluf_(bhi(uw[dt].x)) * (acc[dt][1] + bs) * siluf_(bhi(zw[dt].x));
            const float y2 = geluf_(blo(uw[dt].y)) * (acc[dt][2] + bs) * siluf_(blo(zw[dt].y)), y3 = geluf_(bhi(uw[dt].y)) * (acc[dt][3] + bs) * siluf_(bhi(zw[dt].y));
            v2u w; w.x = pk2(y0, y1); w.y = pk2(y2, y3);
            *(v2u*)(ypc + 16 * dt) = w;
        }
    }
}

constexpr int ML_QS = 0, ML_KS = 26624, ML_KTS = 53248, ML_VTS = 79360, ML_CB = 109824, ML_GA = 133120, ML_GSTRIDE = 2688, ML_CW = 138496;
#define ML_ISSUE_LOADS(cc, TT)                                                                                                           \
    do {                                                                                                                                    \
        _Pragma("unroll") for (int itx = 0; itx < 3; ++itx) { const int idx = (TT) + 512 * itx, tk = idx / 12, dcx = idx - 12 * tk;         \
            const bf16* xp = P + (row0 + 128 * (cc) + tk) * NPJ + PMQ + h * 96 + 8 * dcx;                                                   \
            rq[itx] = *(const v4u*)xp; rk[itx] = *(const v4u*)(xp + (PMK - PMQ)); }                                                         \
        _Pragma("unroll") for (int itx = 0; itx < 3; ++itx) { const int idx = (TT) + 512 * itx, tk = idx & 127, dcx = idx >> 7;             \
            vv[itx] = *(const v4u*)(P + (row0 + 128 * (cc) + tk) * NPJ + PMV + h * 96 + 8 * dcx); }                                         \
        if ((TT) < 144) {                                                                                                                   \
            const int fi = (TT) / 24, rem = (TT) - 24 * fi, qk = rem / 12, dcx = rem - 12 * qk, jj = fi % 3, lr = (fi >= 3 ? 64 : 0) + jj;  \
            const int pp = 128 * (cc) + lr;                                                                                                 \
            const size_t colp = (size_t)(qk ? PMK : PMQ) + h * 96 + 8 * dcx;                                                                \
            const bf16* hb = HB + ((size_t)((row0 + pp) / 64) - 1) * 3 * 768 + qk * 384 + h * 96 + 8 * dcx;                                 \
            _Pragma("unroll") for (int d = 0; d < 4; ++d) {                                                                                 \
                v4u val = (v4u){0u, 0u, 0u, 0u};                                                                                            \
                if (pp - d >= 0) { if (d <= jj) val = *(const v4u*)(P + (row0 + pp - d) * NPJ + colp); else val = *(const v4u*)(hb + (size_t)(3 + jj - d) * 768); } \
                fx[3 - d] = val;                                                                                                            \
            }                                                                                                                               \
        }                                                                                                                                   \
    } while (0)
#define ML_GATES(cc, LN)                                                                                                                   \
    do {                                                                                                                                    \
        LAS float* GBw = (LAS float*)(lds + ML_GA + ((cc) & 1) * ML_GSTRIDE);                                                               \
        const int s0 = 2 * (LN);                                                                                                            \
        const float i0 = gi0 + bih, f0 = gf0 + bfh, i1 = gi1 + bih, f1 = gf1 + bfh;                                                         \
        if ((cc) < 15) { const float* gp = gate + (row0 + 128 * ((cc) + 1) + s0) * 8; gi0 = gp[h]; gf0 = gp[4 + h]; gi1 = gp[8 + h]; gf1 = gp[12 + h]; } \
        const float lf0 = logsigf_(f0), lf1 = logsigf_(f1);                                                                                 \
        const float p = lf0 + lf1; float inc = p;                                                                                           \
        _Pragma("unroll") for (int off = 1; off < 64; off <<= 1) { const float v = __shfl_up(inc, off); if ((LN) >= off) inc += v; }        \
        const float bc0 = (inc - p) + lf0, bc1 = inc;                                                                                       \
        const float a0 = i0 - bc0, a1 = i1 - bc1;                                                                                           \
        float incm = fmaxf(a0, a1);                                                                                                         \
        _Pragma("unroll") for (int off = 1; off < 64; off <<= 1) { const float v = __shfl_up(incm, off); if ((LN) >= off) incm = fmaxf(incm, v); } \
        float excm = __shfl_up(incm, 1); if ((LN) == 0) excm = -INFINITY;                                                                   \
        const float M0 = fmaxf(m_prev, fmaxf(excm, a0)), M1 = fmaxf(m_prev, incm);                                                          \
        const float M127 = __shfl(M1, 63), btot = __shfl(bc1, 63);                                                                          \
        GBw[s0] = a0 * LOG2E; GBw[s0 + 1] = a1 * LOG2E; GBw[128 + s0] = M0 * LOG2E; GBw[129 + s0] = M1 * LOG2E;                             \
        GBw[256 + s0] = fexp(m_prev - M0); GBw[257 + s0] = fexp(m_prev - M1);                                                               \
        GBw[384 + s0] = fexp(-(bc0 + M0)); GBw[385 + s0] = fexp(-(bc1 + M1));                                                               \
        GBw[512 + s0] = fexp(a0 - M127); GBw[513 + s0] = fexp(a1 - M127);                                                                   \
        if ((LN) == 0) GBw[640] = fexp(m_prev - M127);                                                                                      \
        m_prev = btot + M127;                                                                                                               \
    } while (0)
__device__ __forceinline__ void mlstm_unit(LAS unsigned char* lds, const bf16* P, const bf16* HB, const float* gate, bf16* Y, const float* convw, const float* convb, const float* bi, const float* bfv, const float* hn,
                                           int b, int h, int tid, int wid, int lane, const int mode = 0) {
    LAS bf16* QS = (LAS bf16*)(lds + ML_QS);
    LAS bf16* KS = (LAS bf16*)(lds + ML_KS);
    LAS bf16* KTS = (LAS bf16*)(lds + ML_KTS);
    LAS bf16* VTS = (LAS bf16*)(lds + ML_VTS);
    LAS bf16* CB = (LAS bf16*)(lds + ML_CB);
    const int tq = lane & 15, quad = lane >> 4;
    const size_t row0 = (size_t)b * SEQ;
    for (int i = tid; i < 112 * 104 / 2; i += 512) ((LAS unsigned*)CB)[i] = 0u;
    for (int i = tid; i < 16 * 136; i += 512) VTS[96 * 136 + i] = (i < 136) ? (bf16)0x3F80 : (bf16)0;
    LAS float* CW = (LAS float*)(lds + ML_CW);
    LAS float* HNL = (LAS float*)(lds + ML_CW + 3840);
    if (tid < 96) HNL[tid] = hn[h * 96 + tid];
    for (int i = tid; i < 960; i += 512) { const int qk = i / 480, r = i - 480 * qk, tap = r / 96, ch = r - 96 * tap; CW[i] = tap < 4 ? convw[tap * 768 + qk * 384 + h * 96 + ch] : convb[qk * 384 + h * 96 + ch]; }
    f32x4 Cm[6];
#pragma unroll
    for (int i = 0; i < 6; ++i) Cm[i] = (f32x4){0.f, 0.f, 0.f, 0.f};
    float m_prev = 0.f;
    const float bih = bi[h], bfh = bfv[h];
    __syncthreads();
    float gi0 = 0.f, gf0 = 0.f, gi1 = 0.f, gf1 = 0.f;
    if (wid == 0) { const float* gp = gate + (row0 + 2 * lane) * 8; gi0 = gp[h]; gf0 = gp[4 + h]; gi1 = gp[8 + h]; gf1 = gp[12 + h]; }
    if (wid == 0 && !(mode & 16)) ML_GATES(0, lane);
    v4u rq[3], rk[3], fx[4]; v4u vv[3];
#pragma unroll
    for (int d = 0; d < 4; ++d) fx[d] = (v4u){0u, 0u, 0u, 0u};
    ML_ISSUE_LOADS(0, tid);
    for (int c = 0; c < 16; ++c) {
        const size_t tok0 = row0 + 128 * c;
        int tidc = tid, lanec = lane; asm volatile("" : "+v"(tidc), "+v"(lanec));
        const int tq = lanec & 15, quad = lanec >> 4;
        LAS float* GA = (LAS float*)(lds + ML_GA + (c & 1) * ML_GSTRIDE); LAS float* GM = GA + 128; LAS float* GWI = GA + 256; LAS float* GFL = GA + 384; LAS float* GWS = GA + 512; LAS float* GSC = GA + 640;
#pragma unroll
        for (int itx = 0; itx < 3; ++itx) { const int idx = tidc + 512 * itx, tk = idx / 12, dcx = idx - 12 * tk;
            if ((tk & 63) >= 3) { *(LAS v4u*)(QS + tk * 104 + 8 * dcx) = rq[itx]; *(LAS v4u*)(KS + tk * 104 + 8 * dcx) = rk[itx]; } }
        if (tidc < 144) {
            const int fi = tidc / 24, rem = tidc - 24 * fi, qk = rem / 12, dcx = rem - 12 * qk, lr = (fi >= 3 ? 64 : 0) + fi % 3;
            const LAS float* cwp = CW + qk * 480 + 8 * dcx;
            const f32x4 cb0 = *(const LAS f32x4*)(cwp + 384), cb1 = *(const LAS f32x4*)(cwp + 388);
            f32x4 a0 = cb0, a1 = cb1;
#pragma unroll
            for (int tap = 0; tap < 4; ++tap) {
                const f32x4 w0 = *(const LAS f32x4*)(cwp + tap * 96), w1 = *(const LAS f32x4*)(cwp + tap * 96 + 4);
                const v4u xw = fx[tap];
                a0[0] = __builtin_fmaf(w0[0], blo(xw.x), a0[0]); a0[1] = __builtin_fmaf(w0[1], bhi(xw.x), a0[1]); a0[2] = __builtin_fmaf(w0[2], blo(xw.y), a0[2]); a0[3] = __builtin_fmaf(w0[3], bhi(xw.y), a0[3]);
                a1[0] = __builtin_fmaf(w1[0], blo(xw.z), a1[0]); a1[1] = __builtin_fmaf(w1[1], bhi(xw.z), a1[1]); a1[2] = __builtin_fmaf(w1[2], blo(xw.w), a1[2]); a1[3] = __builtin_fmaf(w1[3], bhi(xw.w), a1[3]);
            }
            const float sc = qk ? 0.10206207261596575f : 1.0f;
            v4u o;
            o.x = pk2(siluf_(a0[0]) * sc, siluf_(a0[1]) * sc); o.y = pk2(siluf_(a0[2]) * sc, siluf_(a0[3]) * sc);
            o.z = pk2(siluf_(a1[0]) * sc, siluf_(a1[1]) * sc); o.w = pk2(siluf_(a1[2]) * sc, siluf_(a1[3]) * sc);
            *(LAS v4u*)((qk ? KS : QS) + lr * 104 + 8 * dcx) = o;
        }
#pragma unroll
        for (int itx = 0; itx < 3; ++itx) {
            if (mode & 2) { if (vv[itx][0] == 0x12345678u) VTS[tidc] = 1; continue; }
            const int idx = tidc + 512 * itx, tk = idx & 127, dcx = idx >> 7;
#pragma unroll
            for (int i = 0; i < 4; ++i) { VTS[(8 * dcx + 2 * i) * 136 + tk] = (bf16)(vv[itx][i] & 0xffffu); VTS[(8 * dcx + 2 * i + 1) * 136 + tk] = (bf16)(vv[itx][i] >> 16); }
        }
        LBAR();
        v2u owp[6], zwp[6];
        {
            const bf16* op = P + (tok0 + 16 * wid + tq) * NPJ + PMO + h * 96 + 4 * quad;
#pragma unroll
            for (int et = 0; et < 6; ++et) { owp[et] = *(const v2u*)(op + 16 * et); zwp[et] = *(const v2u*)(op + (PMZ - PMO) + 16 * et); }
        }
        if (c < 15) ML_ISSUE_LOADS(c + 1, tidc);
#pragma unroll
        for (int itx = 0; itx < 3; ++itx) {
            if (mode & 2) break;
            const int idx = tidc + 512 * itx, s = idx & 127, dcx = idx >> 7;
            const v4u kw = *(const LAS v4u*)(KS + s * 104 + 8 * dcx);
            const float wv = GWS[s];
#pragma unroll
            for (int i = 0; i < 4; ++i) { const unsigned pw = pk2(blo(kw[i]) * wv, bhi(kw[i]) * wv); KTS[(8 * dcx + 2 * i) * 136 + s] = (bf16)(pw & 0xffffu); KTS[(8 * dcx + 2 * i + 1) * 136 + s] = (bf16)(pw >> 16); }
        }
        if (!(mode & 4)) {
            const int tt = 16 * wid + tq;
            bf16x8 Bq[3];
#pragma unroll
            for (int kk = 0; kk < 3; ++kk) Bq[kk] = *(const LAS bf16x8*)(QS + tt * 104 + 32 * kk + 8 * quad);
            f32x4 acc[7];
            const float wi = GWI[tt];
#pragma unroll
            for (int et = 0; et < 7; ++et) {
                f32x4 a = (f32x4){0.f, 0.f, 0.f, 0.f};
#pragma unroll
                for (int kk = 0; kk < 3; ++kk) a = mfma16(*(const LAS bf16x8*)(CB + (16 * et + tq) * 104 + 32 * kk + 8 * quad), Bq[kk], a);
                acc[et] = a * wi;
            }
            const float Mt2 = GM[tt];
            int ttl = tt; asm volatile("" : "+v"(ttl));
#pragma unroll
            for (int p = 0; p < 4; ++p) {
                if (2 * p <= wid) {
                    float sv[2][4];
#pragma unroll
                    for (int u = 0; u < 2; ++u) {
                        const int st = 2 * p + u;
                        if (st > wid) {
#pragma unroll
                            for (int j = 0; j < 4; ++j) sv[u][j] = 0.f;
                        } else {
                            f32x4 z = (f32x4){0.f, 0.f, 0.f, 0.f};
#pragma unroll
                            for (int kk = 0; kk < 3; ++kk) z = mfma16(*(const LAS bf16x8*)(KS + (16 * st + tq) * 104 + 32 * kk + 8 * quad), Bq[kk], z);
                            const f32x4 a4 = *(const LAS f32x4*)(GA + 16 * st + 4 * quad);
#pragma unroll
                            for (int j = 0; j < 4; ++j) { float val = z[j] * fexp2(a4[j] - Mt2); if (16 * st + 4 * quad + j > ttl) val = 0.f; sv[u][j] = val; }
                        }
                    }
                    const bf16x8 Bf = mk8(pk2(sv[0][0], sv[0][1]), pk2(sv[0][2], sv[0][3]), pk2(sv[1][0], sv[1][1]), pk2(sv[1][2], sv[1][3]));
#pragma unroll
                    for (int et = 0; et < 7; ++et) {
                        const v2u lo = *(const LAS v2u*)(VTS + (16 * et + tq) * 136 + 32 * p + 4 * quad), hi = *(const LAS v2u*)(VTS + (16 * et + tq) * 136 + 32 * p + 16 + 4 * quad);
                        acc[et] = mfma16(mk8(lo.x, lo.y, hi.x, hi.y), Bf, acc[et]);
                    }
                }
            }
            const float den = __shfl(acc[6][0], tq);
            const float inv = 1.0f / fmaxf(fabsf(den), GFL[tt]);
            float ss = 0.f;
#pragma unroll
            for (int et = 0; et < 6; ++et) { acc[et] = acc[et] * inv; ss += (acc[et][0] * acc[et][0] + acc[et][1] * acc[et][1]) + (acc[et][2] * acc[et][2] + acc[et][3] * acc[et][3]); }
            ss += __shfl_xor(ss, 16); ss += __shfl_xor(ss, 32);
            const float rs = __builtin_amdgcn_rsqf(ss * (1.0f / 96.0f) + EPSN);
            const size_t row = tok0 + tt;
            bf16* yp = Y + row * DM + 256 + h * 96 + 4 * quad;
#pragma unroll
            for (int et = 0; et < 6; ++et) {
                const v2u ow = owp[et], zw = zwp[et];
                const f32x4 hv = *(const LAS f32x4*)(HNL + 16 * et + 4 * quad);
                const float y0 = acc[et][0] * rs * hv[0] * blo(ow.x) * blo(zw.x), y1 = acc[et][1] * rs * hv[1] * bhi(ow.x) * bhi(zw.x);
                const float y2 = acc[et][2] * rs * hv[2] * blo(ow.y) * blo(zw.y), y3 = acc[et][3] * rs * hv[3] * bhi(ow.y) * bhi(zw.y);
                v2u w; w.x = pk2(y0, y1); w.y = pk2(y2, y3);
                *(v2u*)(yp + 16 * et) = w;
            }
        }
        if (wid == 0 && c < 15 && !(mode & 16)) ML_GATES(c + 1, lanec);
        LBAR();
        if (!(mode & 8)) {
            const float decay = GSC[0];
#pragma unroll
            for (int i = 0; i < 6; ++i) {
                const int idx = wid + 8 * i;
                if (idx < 42) {
                    const int et = idx / 6, dtl = idx - 6 * et;
                    f32x4 tmp = (f32x4){0.f, 0.f, 0.f, 0.f};
#pragma unroll
                    for (int kk = 0; kk < 4; ++kk)
                        tmp = mfma16(*(const LAS bf16x8*)(VTS + (16 * et + tq) * 136 + 32 * kk + 8 * quad), *(const LAS bf16x8*)(KTS + (16 * dtl + tq) * 136 + 32 * kk + 8 * quad), tmp);
                    Cm[i] = Cm[i] * decay + tmp;
#pragma unroll
                    for (int j = 0; j < 4; ++j) CB[(16 * et + 4 * quad + j) * 104 + 16 * dtl + tq] = (bf16)(pk2(Cm[i][j], 0.f) & 0xffffu);
                }
            }
        }
        LBAR();
    }
}

struct LayerP {
    const float *gv, *gws, *gbs, *convw, *convb, *bi, *bfv, *hn, *gq, *gk; const bf16* halo;
};
__device__ __forceinline__ int p3_fetch_(volatile LAS int* s_unit, unsigned* counter, int tid, int& pre, int& pre2, int& nxt) {
    LBAR();
    if (tid == 0) { s_unit[0] = pre; s_unit[1] = pre2; }
    LBAR();
    const int u = __builtin_amdgcn_readfirstlane(s_unit[0]);
    nxt = __builtin_amdgcn_readfirstlane(s_unit[1]);
    if (tid == 0) { pre = pre2; pre2 = (int)atomicAdd(counter, 1u); }
    return u;
}
__device__ __forceinline__ void p3_phase(LAS unsigned char* lds, const bf16* P, const float* gate, bf16* Y, const LayerP& lp, unsigned* counter, int tid, int wid, int lane, const int ubase = 0, const int uend = N_UNITS, const int mode = 0) {
    volatile LAS int* s_unit = (volatile LAS int*)(lds + LDS_BYTES - 64);
#define p3_fetch(a_, b_, c_) (ubase + p3_fetch_(a_, b_, c_, pre, pre2, nxt_))
    int pre = 0, pre2 = 0, nxt_ = 0; if (tid == 0) { pre = (int)atomicAdd(counter, 1u); pre2 = (int)atomicAdd(counter, 1u); }
    int u = p3_fetch(s_unit, counter, tid);
#ifndef SKIP_ML
    while (u < N_ML && u < uend) { mlstm_unit(lds, P, lp.halo, gate, Y, lp.convw, lp.convb, lp.bi, lp.bfv, lp.hn, u >> 2, u & 3, tid, wid, lane, mode); u = p3_fetch(s_unit, counter, tid); }
#endif
#ifndef SKIP_AT
    {
        AtPre pf; bool have = false;
#pragma unroll
        for (int i = 0; i < 2; ++i) { pf.k[i] = (v4u){0u, 0u, 0u, 0u}; pf.v[i] = (v4u){0u, 0u, 0u, 0u}; pf.q[i] = (v4u){0u, 0u, 0u, 0u}; }
        while (u < N_ML + N_AT && u < uend) {
            const int idx = u - N_ML, qb = 15 - idx / 192, rem = idx % 192;
            const int nu = ubase + nxt_; const bool nvalid = nu < N_ML + N_AT && nu < uend; const int nidx = nu - N_ML, nqb = 15 - nidx / 192, nrem = nidx % 192;
            attn_unit(lds, P, Y, lp.gq, lp.gk, rem / 6, rem % 6, qb, tid, wid, lane, have, pf, nvalid, nrem / 6, nrem % 6, nqb);
            have = nvalid;
            u = p3_fetch(s_unit, counter, tid);
        }
    }
#endif
#ifndef SKIP_GM
    while (u < uend) { const int idx = u - N_ML - N_AT; gmlp_unit(lds, P, Y, lp.gws, lp.gbs, lp.gv, idx >> 4, (idx >> 2) & 3, idx & 3, tid, wid, lane); u = p3_fetch(s_unit, counter, tid); }
#endif
#undef p3_fetch
}

__device__ __forceinline__ void fast_grid_barrier(unsigned* base, int seam, int tid) {
    asm volatile("s_waitcnt vmcnt(0)" ::: "memory");
    __syncthreads();
    if (tid == 0) {
        unsigned* cnt = base + seam * 128;
        unsigned* flg = cnt + 64;
        __builtin_amdgcn_fence(__ATOMIC_RELEASE, "agent");
        asm volatile("s_waitcnt vmcnt(0)" ::: "memory");
        const unsigned old = __hip_atomic_fetch_add(cnt, 1u, __ATOMIC_RELAXED, __HIP_MEMORY_SCOPE_AGENT);
        if (old == gridDim.x - 1) __hip_atomic_store(flg, 1u, __ATOMIC_RELAXED, __HIP_MEMORY_SCOPE_AGENT);
        else { unsigned sp = 0; while (__hip_atomic_load(flg, __ATOMIC_RELAXED, __HIP_MEMORY_SCOPE_AGENT) == 0u) { __builtin_amdgcn_s_sleep(2); if (++sp > (1u << 22)) break; } }
        __builtin_amdgcn_fence(__ATOMIC_ACQUIRE, "agent");
        asm volatile("s_waitcnt vmcnt(0)" ::: "memory");
    }
    __syncthreads();
}

#ifndef P3_WID
#define P3_WID wid
#endif
#ifndef DUP_MODE
#define DUP_MODE 0
#endif
struct Args { const float* in[17]; float* out; unsigned char* ws; int ph_lo, ph_hi; };
struct RowOrder {
    int c;
    __device__ __forceinline__ bool next(int i, pg8::Unit& u) const { if (i >= DM / 256) return false; u.pm = c; u.pn = i; return true; }
    __device__ __forceinline__ void a_ready(const pg8::Unit&) const {}
    __device__ __forceinline__ void done(const pg8::Unit&) const {}
};
typedef const __attribute__((address_space(4))) Args* KArgP;
template <int PH>
__device__ __forceinline__ void run_phase(LAS unsigned char* lds, int tid, int wid, int lane) {
#if defined(__HIP_DEVICE_COMPILE__)
    KArgP ap = (KArgP)__builtin_amdgcn_kernarg_segment_ptr(); asm volatile("" : "+s"(ap));
    const Args a = *ap;
#else
    const Args a{};
#endif
    unsigned char* ws = a.ws;
    float* mod = (float*)(ws + WS_MOD); float* gate = (float*)(ws + WS_GATE);
    bf16* win_t = (bf16*)(ws + WS_WIN); bf16* wout_t = (bf16*)(ws + WS_WOUT);
    bf16* H = (bf16*)(ws + WS_H); bf16* PJ = (bf16*)(ws + WS_PROJ);
    if constexpr (PH == 0) {
#ifndef SKIP_P0
        p0_phase(lds, a.in[1], a.in[3], a.in[4], a.in[5], a.in[16], mod, win_t, wout_t, tid, wid, lane);
#endif
    } else {
        constexpr int l = (PH - 1) >> 2, sub = (PH - 1) & 3;
        const float* xin = l == 0 ? a.in[0] : a.out;
        if constexpr (sub == 0) {
#ifndef SKIP_P1
            p1_phase(xin, a.in[2] + l * DM, mod + (size_t)l * 32 * 3072, H, wid, lane);
#endif
        } else if constexpr (sub == 1) {
#ifndef SKIP_G1
            pg8::Gemm g{H, win_t + (size_t)l * WIN_ELEMS, MTOK, NPJ, DM}; pg8::StaticOrder S; S.init(MTOK, NPJ, (int)gridDim.x, (int)blockIdx.x);
            EpiProj E{PJ, gate, a.in[9] + l * 4 * 768, a.in[10] + l * 768, (bf16*)(ws + WS_HALO)};
            pg8::gemm_phase<EpiProj, pg8::StaticOrder, true, true>(lds, g, S, E);
#if defined(DUP_P2)
            if (l == 0) { __syncthreads(); pg8::gemm_phase<EpiProj, pg8::StaticOrder, true, true>(lds, g, S, E); }
#endif
#endif
        } else if constexpr (sub == 2) {
            LayerP lp;
            lp.gv = a.in[6] + l * 256; lp.gws = a.in[7] + (size_t)l * 4 * 128 * 128; lp.gbs = a.in[8] + l * 512; lp.convw = a.in[9] + l * 4 * 768; lp.convb = a.in[10] + l * 768;
            lp.bi = a.in[11] + l * 4; lp.bfv = a.in[12] + l * 4; lp.hn = a.in[13] + l * 384; lp.gq = a.in[14] + l * 64; lp.gk = a.in[15] + l * 64; lp.halo = (const bf16*)(ws + WS_HALO);
            p3_phase(lds, PJ, gate, H, lp, (unsigned*)(ws + WS_CTL) + 64 * l, tid, P3_WID, lane);
#if defined(DUP_P3)
            if (l == 0) { __syncthreads(); p3_phase(lds, PJ, gate, (bf16*)(ws + 800 * MiB), lp, (unsigned*)(ws + WS_CTL) + 64 * (l + 2), tid, P3_WID, lane, DUP_LO, DUP_HI, DUP_MODE); }
#endif
        } else {
#ifndef SKIP_G2
            pg8::Gemm g{H, wout_t + (size_t)l * WOUT_ELEMS, MTOK, DM, DM};
            EpiOut E{xin, a.out, mod + (size_t)l * 32 * 3072 + 2048};
            if (l == 0 && gridDim.x == MTOK / 256) {
                RowOrder S{(int)blockIdx.x};
                pg8::gemm_phase<EpiOut, RowOrder, true, true>(lds, g, S, E);
                asm volatile("s_waitcnt vmcnt(0)" ::: "memory");
                __syncthreads();
                __builtin_amdgcn_fence(__ATOMIC_ACQUIRE, "agent");
                p1_phase(a.out, a.in[2] + DM, mod + (size_t)32 * 3072, H, wid, lane);
            } else {
                pg8::StaticOrder S; S.init(MTOK, DM, (int)gridDim.x, (int)blockIdx.x);
                pg8::gemm_phase<EpiOut, pg8::StaticOrder, true, true>(lds, g, S, E);
            }
#endif
        }
    }
}
__global__ void __launch_bounds__(512, 2) hybrid_fwd(Args a) {
    extern __shared__ __attribute__((aligned(16))) unsigned char lds_raw[];
    LAS unsigned char* lds = (LAS unsigned char*)lds_raw;
    const int tid = threadIdx.x, lane = tid & 63, wid = __builtin_amdgcn_readfirstlane(tid >> 6);
    const int lo = a.ph_lo, hi = a.ph_hi;
#define IN(k) (lo <= (k) && (k) < hi)
#ifdef DUP_SYNC
#define EXTRA_SYNC() do { cg::this_grid().sync(); cg::this_grid().sync(); } while (0)
#else
#define EXTRA_SYNC() do { } while (0)
#endif
#define SEAM(k) fast_grid_barrier((unsigned*)(a.ws + 1024), (k), tid)
#define PHASE(k) do { if (IN(k)) { run_phase<k>(lds, tid, wid, lane); if (IN((k) + 1)) { SEAM(k); EXTRA_SYNC(); } } } while (0)
    if (hi > NPHASE) cg::this_grid().sync();
    const bool fused45 = (gridDim.x == MTOK / 256) && IN(4) && IN(5);
    PHASE(0); PHASE(1); PHASE(2); PHASE(3);
    if (fused45) { run_phase<4>(lds, tid, wid, lane); if (IN(6)) SEAM(5); }
    else { PHASE(4); PHASE(5); }
    PHASE(6); PHASE(7); PHASE(8);
#undef PHASE
#undef IN
}

extern "C" void kernel_launch(void* const* d_in, const int* in_sizes, int n_in, void* d_out, int out_size, void* d_ws, size_t ws_size, hipStream_t stream) {
    static int grid = 0;
    if (grid == 0) {
        if (n_in != 17 || out_size != MTOK * DM || ws_size < WS_END) { fprintf(stderr, "kernel_launch: unexpected shapes (n_in %d out %d ws %zu)\n", n_in, out_size, ws_size); grid = -1; return; }
        int dev = 0, cus = 0, per_cu = 0;
        (void)hipGetDevice(&dev);
        (void)hipDeviceGetAttribute(&cus, hipDeviceAttributeMultiprocessorCount, dev);
        if (hipFuncSetAttribute((const void*)hybrid_fwd, hipFuncAttributeMaxDynamicSharedMemorySize, LDS_BYTES) != hipSuccess) { fprintf(stderr, "kernel_launch: hipFuncSetAttribute failed\n"); }
        if (hipOccupancyMaxActiveBlocksPerMultiprocessor(&per_cu, (const void*)hybrid_fwd, 512, LDS_BYTES) != hipSuccess || per_cu < 1) { fprintf(stderr, "kernel_launch: occupancy query gave %d\n", per_cu); per_cu = 1; }
        (void)hipGetLastError();
        if (cus <= 0) cus = 256;
        grid = cus * 1;
        (void)per_cu;
    }
    if (grid < 0) return;
    (void)hipMemsetAsync((char*)d_ws + WS_CTL, 0, 8192, stream);
    Args a{};
    for (int i = 0; i < 17; ++i) a.in[i] = (const float*)d_in[i];
    a.out = (float*)d_out; a.ws = (unsigned char*)d_ws;
#if ONE_LAUNCH
    a.ph_lo = 0; a.ph_hi = NPHASE;
    void* args[] = {&a};
    hipError_t e = hipLaunchCooperativeKernel((const void*)hybrid_fwd, dim3(grid), dim3(512), args, LDS_BYTES, stream);
    if (e != hipSuccess) fprintf(stderr, "cooperative launch failed: %s (grid %d)\n", hipGetErrorString(e), grid);
#else
    for (int ph = 0; ph < NPHASE; ++ph) {
        a.ph_lo = ph; a.ph_hi = ph + 1;
        hipLaunchKernelGGL(hybrid_fwd, dim3(grid), dim3(512), LDS_BYTES, stream, a);
    }
#endif
}
```

```cpp
#include <hip/hip_runtime.h>
#include <hip/hip_cooperative_groups.h>
#include <cstdio>
#include <cstdint>
namespace cg = cooperative_groups;
#ifndef ONE_LAUNCH
#define ONE_LAUNCH 1
#endif
namespace pg8 {
#define PG8_LAS __attribute__((address_space(3)))
typedef unsigned short bf16_t;
typedef short bf16x8 __attribute__((ext_vector_type(8)));
typedef float f32x4 __attribute__((ext_vector_type(4)));
typedef unsigned u32x4 __attribute__((ext_vector_type(4)));
constexpr int BM = 256, BK = 64, HALF = 128, HTB = HALF * BK * 2  , STAGE_BYTES = 8 * HTB, NXCD = 8, WGM = 8;

__host__ __device__ __forceinline__ int lds_byte(int r, int c) { const int st = (r >> 4) * 2 + (c >> 5), rr = r & 15, cc = c & 31, ob = rr * 64 + cc * 2; return st * 1024 + (ob ^ (((ob >> 9) & 1) << 5)); }
__host__ __device__ __forceinline__ void stage_rc(int b, int& R, int& C) { const int st = b / 1024, sb = b % 1024, swz = sb ^ (((sb >> 9) & 1) << 5); R = (st >> 1) * 16 + swz / 64; C = (st & 1) * 32 + (swz % 64) / 2; }
__host__ __device__ __forceinline__ int perm32(int rho) { const int n = rho >> 4, i = rho & 15; return 8 * (i >> 2) + 4 * n + (i & 3); }

struct Unit { int pm, pn; };
struct Gemm { const bf16_t* A; const bf16_t* Bt; int M, N, K; };

struct StaticOrder {
    int nM, nN, nwg, G, c;
    __host__ __device__ void init(int M, int N, int G_, int c_) { nM = M / BM; nN = N / BM; nwg = nM * nN; G = G_; c = c_; }
    __host__ __device__ bool next(int i, Unit& u) const {
        const long L = (long)i * G + c; if (L >= nwg) return false;
        int wgid = (int)L; { const int q = nwg / NXCD, r = nwg % NXCD, xcd = wgid % NXCD, off = wgid / NXCD; wgid = (xcd < r ? xcd * (q + 1) : r * (q + 1) + (xcd - r) * q) + off; }
        const int nig = WGM * nN, gid = wgid / nig, fm = gid * WGM, gsz = (nM - fm) < WGM ? (nM - fm) : WGM;
        u.pm = fm + ((wgid % nig) % gsz); u.pn = (wgid % nig) / gsz; return true;
    }
    __device__ __forceinline__ void a_ready(const Unit&) const {}
    __device__ __forceinline__ void done(const Unit&) const {}
};

__device__ __forceinline__ unsigned cvt_pk_bf16(float lo, float hi) { unsigned r; asm volatile("v_cvt_pk_bf16_f32 %0, %1, %2" : "=v"(r) : "v"(lo), "v"(hi)); return r; }
template <class Epi, class Sched, bool ALIGN_EPI = false, bool SP2 = false>
__device__ __forceinline__ void gemm_phase(PG8_LAS unsigned char* lds, const Gemm g, const Sched& S, const Epi& E) {
    int tid_ = threadIdx.x; asm volatile("" : "+v"(tid_));
    const int tid = tid_, wid = __builtin_amdgcn_readfirstlane(tid >> 6), lane = tid & 63, wr = wid >> 2, wc = wid & 3, fr = lane & 15, fq = lane >> 4;
    const int K = g.K, nt = K / BK;
    unsigned voffA[2], voffB[2];
#pragma unroll
    for (int i = 0; i < 2; ++i) { int R, C; stage_rc(tid * 16 + i * 8192, R, C); const int Rb = Epi::PERM ? ((R & ~31) + perm32(R & 31)) : R;
        voffA[i] = (unsigned)(R * K + C) * 2u; voffB[i] = (unsigned)(Rb * K + C) * 2u; }
    const size_t kstep = (size_t)(BK * 2);
    const size_t hstep = (size_t)HALF * K * 2;
    const size_t tstep = 2 * hstep;
    const unsigned ldsw = (unsigned)wid * 1024u;
    const int aoff = lds_byte(wr * 64 + fr, fq * 8), boff = lds_byte(wc * 32 + fr, fq * 8);
#define PG8_SA(b, h) (((b) * 2 + (h)) * HTB)
#define PG8_SB(b, h) ((4 + (b) * 2 + (h)) * HTB)
#define PG8_STAGE(bufoff, gbase, voff) do { _Pragma("unroll") for (int _i = 0; _i < 2; ++_i) \
        __builtin_amdgcn_global_load_lds((const unsigned*)((const char*)(gbase) + (voff)[_i]), (PG8_LAS unsigned*)(lds + (bufoff) + ldsw + _i * 8192), 16, 0, 0); } while (0)
#define PG8_LDA(dst, b, h) do { _Pragma("unroll") for (int m = 0; m < 4; ++m) _Pragma("unroll") for (int k = 0; k < 2; ++k) dst[m][k] = *(const PG8_LAS bf16x8*)(lds + PG8_SA(b, h) + aoff + m * 2048 + k * 1024); } while (0)
#define PG8_LDB(dst, b, h) do { _Pragma("unroll") for (int n = 0; n < 2; ++n) _Pragma("unroll") for (int k = 0; k < 2; ++k) dst[n][k] = *(const PG8_LAS bf16x8*)(lds + PG8_SB(b, h) + boff + n * 2048 + k * 1024); } while (0)
#define PG8_MMA(ai, bj, At, Bt) do { __builtin_amdgcn_s_setprio(1); _Pragma("unroll") for (int m = 0; m < 4; ++m) _Pragma("unroll") for (int n = 0; n < 2; ++n) _Pragma("unroll") for (int k = 0; k < 2; ++k) \
        acc[ai][bj][m][n] = __builtin_amdgcn_mfma_f32_16x16x32_bf16(Bt[n][k], At[m][k], acc[ai][bj][m][n], 0, 0, 0); __builtin_amdgcn_s_setprio(0); } while (0)
#define PG8_WAIT_V(n) asm volatile("s_waitcnt vmcnt(" #n ")" ::: "memory")
#define PG8_WAIT_L(n) asm volatile("s_waitcnt lgkmcnt(" #n ")" ::: "memory")
#define PG8_BAR __builtin_amdgcn_s_barrier()
#define PG8_SCHED __builtin_amdgcn_sched_barrier(0)
    Unit cur, nxt; int ui = 0;
    if (!S.next(0, cur)) return;
    f32x4 acc[2][2][4][2];
#pragma unroll
    for (int a = 0; a < 2; ++a)
#pragma unroll
        for (int b = 0; b < 2; ++b)
#pragma unroll
            for (int m = 0; m < 4; ++m)
#pragma unroll
                for (int n = 0; n < 2; ++n) acc[a][b][m][n] = (f32x4){0.f, 0.f, 0.f, 0.f};
    bf16x8 At[4][2], B0[2][2], B1[2][2];
    const char* cA = (const char*)g.A + (size_t)cur.pm * tstep; const char* cB = (const char*)g.Bt + (size_t)cur.pn * tstep;
    S.a_ready(cur);
    if constexpr (SP2) {
        PG8_STAGE(PG8_SB(0, 0), cB, voffB); PG8_STAGE(PG8_SB(0, 1), cB + hstep, voffB); PG8_STAGE(PG8_SA(0, 0), cA, voffA); PG8_STAGE(PG8_SA(0, 1), cA + hstep, voffA);
        if (wr == 1) PG8_BAR;
        PG8_WAIT_V(2); PG8_BAR;
        PG8_STAGE(PG8_SB(1, 0), cB + kstep, voffB); PG8_STAGE(PG8_SA(1, 0), cA + kstep, voffA); PG8_STAGE(PG8_SB(1, 1), cB + hstep + kstep, voffB);
        PG8_WAIT_V(6); PG8_BAR;
    } else {
        PG8_STAGE(PG8_SB(0, 0), cB, voffB); PG8_STAGE(PG8_SA(0, 0), cA, voffA); PG8_STAGE(PG8_SB(0, 1), cB + hstep, voffB); PG8_STAGE(PG8_SA(0, 1), cA + hstep, voffA);
        if (wr == 1) PG8_BAR;
        PG8_WAIT_V(4); PG8_BAR;
        PG8_STAGE(PG8_SB(1, 0), cB + kstep, voffB); PG8_STAGE(PG8_SA(1, 0), cA + kstep, voffA); PG8_STAGE(PG8_SB(1, 1), cB + hstep + kstep, voffB);
        PG8_WAIT_V(6); PG8_BAR;
    }
    for (;;) {
        const bool has_next = S.next(ui + 1, nxt);
        const char* nA = has_next ? (const char*)g.A + (size_t)nxt.pm * tstep : cA; const char* nB = has_next ? (const char*)g.Bt + (size_t)nxt.pn * tstep : cB;
        for (int t = 0; t < nt; t += 2) {
            const bool last = (t == nt - 2);
            const char* a1 = cA + (size_t)(t + 1) * kstep;
            const char* a2 = last ? nA : cA + (size_t)(t + 2) * kstep; const char* b2 = last ? nB : cB + (size_t)(t + 2) * kstep;
            const char* a3 = a2 + kstep; const char* b3 = b2 + kstep;
            if (last && has_next) S.a_ready(nxt);
            if constexpr (SP2) {
            PG8_LDB(B0, 0, 0); PG8_LDB(B1, 0, 1); PG8_SCHED; PG8_LDA(At, 0, 0); PG8_STAGE(PG8_SA(1, 1), a1 + hstep, voffA);
            PG8_WAIT_V(8); PG8_WAIT_L(0); PG8_BAR; PG8_MMA(0, 0, At, B0); PG8_MMA(0, 1, At, B1); PG8_BAR; PG8_SCHED;
            PG8_LDA(At, 0, 1); PG8_STAGE(PG8_SB(0, 0), b2, voffB); PG8_STAGE(PG8_SB(0, 1), b2 + hstep, voffB); PG8_STAGE(PG8_SA(0, 0), a2, voffA);
            PG8_WAIT_V(8); PG8_WAIT_L(0); PG8_BAR; PG8_MMA(1, 0, At, B0); PG8_MMA(1, 1, At, B1); PG8_BAR; PG8_SCHED;
            PG8_LDB(B0, 1, 0); PG8_LDB(B1, 1, 1); PG8_SCHED; PG8_LDA(At, 1, 0); PG8_STAGE(PG8_SA(0, 1), a2 + hstep, voffA);
            PG8_WAIT_V(8); PG8_WAIT_L(0); PG8_BAR; PG8_MMA(0, 0, At, B0); PG8_MMA(0, 1, At, B1); PG8_BAR; PG8_SCHED;
            PG8_LDA(At, 1, 1); PG8_STAGE(PG8_SB(1, 0), b3, voffB); PG8_STAGE(PG8_SB(1, 1), b3 + hstep, voffB); PG8_STAGE(PG8_SA(1, 0), a3, voffA);
            PG8_WAIT_V(8); PG8_WAIT_L(0); PG8_BAR; PG8_MMA(1, 0, At, B0); PG8_MMA(1, 1, At, B1); PG8_BAR; PG8_SCHED;
            } else {
            PG8_LDB(B0, 0, 0); PG8_SCHED; PG8_LDA(At, 0, 0); PG8_STAGE(PG8_SA(1, 1), a1 + hstep, voffA);
            PG8_WAIT_L(8); PG8_BAR; PG8_WAIT_L(0); PG8_MMA(0, 0, At, B0); PG8_BAR; PG8_SCHED;
            PG8_LDB(B1, 0, 1); PG8_STAGE(PG8_SB(0, 0), b2, voffB);
            PG8_BAR; PG8_WAIT_L(0); PG8_MMA(0, 1, At, B1); PG8_BAR;
            PG8_LDA(At, 0, 1); PG8_STAGE(PG8_SA(0, 0), a2, voffA);
            PG8_BAR; PG8_WAIT_L(0); PG8_MMA(1, 0, At, B0); PG8_BAR; PG8_SCHED;
            PG8_STAGE(PG8_SB(0, 1), b2 + hstep, voffB);
            PG8_WAIT_V(6); PG8_BAR; PG8_MMA(1, 1, At, B1); PG8_BAR;
            PG8_LDB(B0, 1, 0); PG8_SCHED; PG8_LDA(At, 1, 0); PG8_STAGE(PG8_SA(0, 1), a2 + hstep, voffA);
            PG8_WAIT_L(8); PG8_BAR; PG8_WAIT_L(0); PG8_MMA(0, 0, At, B0); PG8_BAR; PG8_SCHED;
            PG8_LDB(B1, 1, 1); PG8_STAGE(PG8_SB(1, 0), b3, voffB);
            PG8_BAR; PG8_WAIT_L(0); PG8_MMA(0, 1, At, B1); PG8_BAR;
            PG8_LDA(At, 1, 1); PG8_STAGE(PG8_SA(1, 0), a3, voffA);
            PG8_BAR; PG8_WAIT_L(0); PG8_MMA(1, 0, At, B0); PG8_BAR; PG8_SCHED;
            PG8_STAGE(PG8_SB(1, 1), b3 + hstep, voffB);
            PG8_WAIT_V(6); PG8_BAR; PG8_MMA(1, 1, At, B1); PG8_BAR;
            }
        }
        if constexpr (ALIGN_EPI) { if (wr == 0) PG8_BAR; }
        if constexpr (!Epi::AFTER_DRAIN) { E(acc, cur, wr, wc, fr, fq); S.done(cur); }
        if (!has_next) break;
#pragma unroll
        for (int a = 0; a < 2; ++a)
#pragma unroll
            for (int b = 0; b < 2; ++b)
#pragma unroll
                for (int m = 0; m < 4; ++m)
#pragma unroll
                    for (int n = 0; n < 2; ++n) acc[a][b][m][n] = (f32x4){0.f, 0.f, 0.f, 0.f};
        cur = nxt; cA = nA; cB = nB; ++ui;
        if constexpr (ALIGN_EPI) { if (wr == 1) PG8_BAR; }
    }
    PG8_WAIT_V(0);
    if constexpr (!ALIGN_EPI) { if (wr == 0) PG8_BAR; }
    PG8_BAR;
    if constexpr (Epi::AFTER_DRAIN) { E.fused(acc, cur, wr, wc, fr, fq, lds, wid, lane); S.done(cur); }
#undef PG8_SA
#undef PG8_SB
#undef PG8_STAGE
#undef PG8_LDA
#undef PG8_LDB
#undef PG8_MMA
#undef PG8_WAIT_V
#undef PG8_WAIT_L
#undef PG8_BAR
#undef PG8_SCHED
}
}

#define LAS __attribute__((address_space(3)))
typedef unsigned short bf16;
typedef unsigned v4u __attribute__((ext_vector_type(4)));
typedef unsigned v2u __attribute__((ext_vector_type(2)));
typedef float f32x4 __attribute__((ext_vector_type(4)));
typedef short bf16x8 __attribute__((ext_vector_type(8)));

constexpr int NB = 32, SEQ = 2048, DM = 1024, MTOK = NB * SEQ, DIN = 4232, NPJ = 4352;
constexpr int PU = 0, PV = 256, PZ = 512, PMQ = 768, PMK = 1152, PMV = 1536, PMO = 1920, PMZ = 2304, PSQ = 2688, PSK = 3072, PSV = 3456, PSZ = 3840, PGI = 4224;
constexpr float EPSN = 1e-6f, LOG2E = 1.4426950408889634f;
constexpr size_t MiB = 1u << 20;
constexpr size_t WS_CTL = 0, WS_MOD = 1 * MiB, WS_GATE = 2 * MiB, WS_WIN = 4 * MiB, WS_WOUT = 22 * MiB, WS_H = 32 * MiB, WS_PROJ = 160 * MiB, WS_HALO = 704 * MiB, WS_END = 712 * MiB;
constexpr size_t WIN_ELEMS = (size_t)NPJ * DM, WOUT_ELEMS = (size_t)DM * DM;
constexpr int LDS_BYTES = 147456;
constexpr int NPHASE = 9;
constexpr int N_ML = 128, N_AT = NB * 6 * 16, N_GM = NB * 4 * 4, N_UNITS = N_ML + N_AT + N_GM;

__device__ __forceinline__ unsigned pk2(float lo, float hi) { unsigned r; asm("v_cvt_pk_bf16_f32 %0, %1, %2" : "=v"(r) : "v"(lo), "v"(hi)); return r; }
__device__ __forceinline__ float blo(unsigned w) { return __uint_as_float(w << 16); }
__device__ __forceinline__ float bhi(unsigned w) { return __uint_as_float(w & 0xffff0000u); }
__device__ __forceinline__ float fexp2(float x) { return __builtin_amdgcn_exp2f(x); }
__device__ __forceinline__ float fexp(float x) { return __builtin_amdgcn_exp2f(x * LOG2E); }
__device__ __forceinline__ float frcp(float x) { return __builtin_amdgcn_rcpf(x); }
__device__ __forceinline__ float sigmoidf_(float x) { return frcp(1.0f + fexp2(-x * LOG2E)); }
__device__ __forceinline__ float siluf_(float x) { return x * sigmoidf_(x); }
__device__ __forceinline__ float geluf_(float x) { const float y = 1.5957691216057308f * (x + 0.044715f * x * x * x); return x * sigmoidf_(y); }
__device__ __forceinline__ float logsigf_(float x) { return fminf(x, 0.f) - 0.6931471805599453f * __builtin_amdgcn_logf(1.0f + fexp2(-fabsf(x) * LOG2E)); }
__device__ __forceinline__ f32x4 mfma16(bf16x8 a, bf16x8 b, f32x4 c) { return __builtin_amdgcn_mfma_f32_16x16x32_bf16(a, b, c, 0, 0, 0); }
__device__ __forceinline__ bf16x8 mk8(unsigned a, unsigned b, unsigned c, unsigned d) { v4u w; w.x = a; w.y = b; w.z = c; w.w = d; return __builtin_bit_cast(bf16x8, w); }
#define LBAR() do { asm volatile("s_waitcnt lgkmcnt(0)" ::: "memory"); __builtin_amdgcn_s_barrier(); asm volatile("" ::: "memory"); } while (0)
__device__ __forceinline__ float wave_sum(float v) {
#pragma unroll
    for (int o = 1; o < 64; o <<= 1) v += __shfl_xor(v, o);
    return v;
}

__device__ __forceinline__ float actf(float x, int act) {
    const float y = act == 1 ? 1.5957691216057308f * (x + 0.044715f * x * x * x) : x;
    const float sg = sigmoidf_(y);
    return act == 3 ? sg : x * sg;
}
template <int K> __device__ __forceinline__ float row_prev(float xm, float xm1) {
    const int o = __builtin_amdgcn_update_dpp(0, __float_as_int(xm1), 0x120 + K, 0xf, 0xf, false);
    return __int_as_float(__builtin_amdgcn_update_dpp(o, __float_as_int(xm), 0x110 + K, 0xf, 0xf, false));
}
struct EpiProj {
    static constexpr bool PERM = true, AFTER_DRAIN = false;
    bf16* O; float* gate; const float* convw; const float* convb; bf16* halo;
    __device__ __forceinline__ void operator()(const f32x4 (&acc)[2][2][4][2], const pg8::Unit& u, int wr, int wc, int fr, int fq) const {
        const int row0 = u.pm * 256 + wr * 64 + fr, col0 = u.pn * 256 + wc * 32 + 8 * fq;
        if (u.pn >= 3 && u.pn <= 5) {
#pragma unroll
            for (int bj = 0; bj < 2; ++bj) {
                const int ch0 = u.pn * 256 + bj * 128 - 768 + wc * 32 + 8 * fq;
                const float sc = ch0 >= 384 ? 0.10206207261596575f : 1.0f;
                float wv[4][8], bv[8];
#pragma unroll
                for (int tap = 0; tap < 4; ++tap) { const f32x4 a = *(const f32x4*)(convw + tap * 768 + ch0), b2 = *(const f32x4*)(convw + tap * 768 + ch0 + 4);
#pragma unroll
                    for (int i = 0; i < 4; ++i) { wv[tap][i] = a[i]; wv[tap][4 + i] = b2[i]; } }
                { const f32x4 a = *(const f32x4*)(convb + ch0), b2 = *(const f32x4*)(convb + ch0 + 4);
#pragma unroll
                  for (int i = 0; i < 4; ++i) { bv[i] = a[i]; bv[4 + i] = b2[i]; } }
#pragma unroll
                for (int ai = 0; ai < 2; ++ai) {
#pragma unroll
                    for (int m = 0; m < 4; ++m) {
                        float o[8];
#pragma unroll
                        for (int i = 0; i < 8; ++i) {
                            const float x0 = acc[ai][bj][m][i >> 2][i & 3];
                            const float xm1 = m > 0 ? acc[ai][bj][m > 0 ? m - 1 : 0][i >> 2][i & 3] : 0.f;
                            const float p1 = row_prev<1>(x0, xm1), p2 = row_prev<2>(x0, xm1), p3 = row_prev<3>(x0, xm1);
                            float y = bv[i];
                            y = __builtin_fmaf(wv[0][i], p3, y); y = __builtin_fmaf(wv[1][i], p2, y); y = __builtin_fmaf(wv[2][i], p1, y); y = __builtin_fmaf(wv[3][i], x0, y);
                            y = siluf_(y) * sc;
                            if (m == 0 && fr < 3) y = x0;
                            o[i] = y;
                        }
                        v4u w; w.x = pk2(o[0], o[1]); w.y = pk2(o[2], o[3]); w.z = pk2(o[4], o[5]); w.w = pk2(o[6], o[7]);
                        *(v4u*)(O + (size_t)(row0 + ai * 128 + m * 16) * NPJ + col0 + bj * 128) = w;
                        if (m == 3 && fr >= 13) {
                            const f32x4 v0 = acc[ai][bj][3][0], v1 = acc[ai][bj][3][1];
                            v4u hw; hw.x = pk2(v0[0], v0[1]); hw.y = pk2(v0[2], v0[3]); hw.z = pk2(v1[0], v1[1]); hw.w = pk2(v1[2], v1[3]);
                            *(v4u*)(halo + ((size_t)((4 * u.pm + 2 * ai + wr) * 3 + (fr - 13))) * 768 + ch0) = hw;
                        }
                    }
                }
            }
            return;
        }
        const unsigned long long SILU_M = (0x7ull << 18), SIGM_M = 0x7ull << 15;
        const int sg0 = 2 * u.pn, sg1 = sg0 + 1;
        const int act0 = ((SILU_M >> sg0) & 1) ? 2 : (((SIGM_M >> sg0) & 1) ? 3 : 0);
        const int act1 = ((SILU_M >> sg1) & 1) ? 2 : (((SIGM_M >> sg1) & 1) ? 3 : 0);
#pragma unroll
        for (int ai = 0; ai < 2; ++ai)
#pragma unroll
            for (int m = 0; m < 4; ++m) {
                bf16* rowp = O + (size_t)(row0 + ai * 128 + m * 16) * NPJ + col0;
#pragma unroll
                for (int bj = 0; bj < 2; ++bj) {
                    f32x4 v0 = acc[ai][bj][m][0], v1 = acc[ai][bj][m][1];
                    const int act = bj ? act1 : act0;
                    if (act) {
#pragma unroll
                        for (int i = 0; i < 4; ++i) { v0[i] = actf(v0[i], act); v1[i] = actf(v1[i], act); }
                    }
                    v4u w; w.x = pk2(v0[0], v0[1]); w.y = pk2(v0[2], v0[3]); w.z = pk2(v1[0], v1[1]); w.w = pk2(v1[2], v1[3]);
                    *(v4u*)(rowp + bj * 128) = w;
                }
            }
        if (u.pn == 16 && wc == 0 && fq == 0) {
#pragma unroll
            for (int ai = 0; ai < 2; ++ai)
#pragma unroll
                for (int m = 0; m < 4; ++m) {
                    float* g = gate + (size_t)(row0 + ai * 128 + m * 16) * 8;
                    *(f32x4*)g = acc[ai][1][m][0]; *(f32x4*)(g + 4) = acc[ai][1][m][1];
                }
        }
    }
};
struct EpiOut {
    static constexpr bool PERM = false, AFTER_DRAIN = false;
    const float* xin; float* out; const float* gatev;
    __device__ __forceinline__ void operator()(const f32x4 (&acc)[2][2][4][2], const pg8::Unit& u, int wr, int wc, int fr, int fq) const {
        const int row0 = u.pm * 256 + wr * 64 + fr, col0 = u.pn * 256 + wc * 32 + 4 * fq;
        const float* gp = gatev + (size_t)(u.pm >> 3) * 3072 + col0;
        f32x4 gv[2][2];
#pragma unroll
        for (int bj = 0; bj < 2; ++bj)
#pragma unroll
            for (int n = 0; n < 2; ++n) gv[bj][n] = *(const f32x4*)(gp + bj * 128 + n * 16);
#pragma unroll
        for (int ai = 0; ai < 2; ++ai)
#pragma unroll
            for (int m = 0; m < 4; ++m) {
                const size_t off = (size_t)(row0 + ai * 128 + m * 16) * DM + col0;
#pragma unroll
                for (int bj = 0; bj < 2; ++bj)
#pragma unroll
                    for (int n = 0; n < 2; ++n) {
                        const f32x4 xv = *(const f32x4*)(xin + off + bj * 128 + n * 16);
                        *(f32x4*)(out + off + bj * 128 + n * 16) = xv + gv[bj][n] * acc[ai][bj][m][n];
                    }
                if (m == 3) asm volatile("" ::: "memory");
            }
    }
};

template <bool WIN>
__device__ __forceinline__ void p0_transpose_item(const float* W, int srcN, bf16* WT, LAS float* scr, int item, int nblk, int lane) {
    const int kb = item / nblk, nb = item % nblk, k0 = 64 * kb, n0 = 32 * nb;
    const int nd = n0 + (lane & 31);
    int sc = nd;
    if (WIN) { sc = nd < PSQ ? nd : (nd < PGI ? nd + 8 : (nd < DIN ? nd - PGI + 2688 : -1)); }
#pragma unroll 8
    for (int i = 0; i < 32; ++i) { const int kk = 2 * i + (lane >> 5); scr[kk * 33 + (lane & 31)] = sc >= 0 ? W[(size_t)(k0 + kk) * srcN + sc] : 0.f; }
    asm volatile("s_waitcnt lgkmcnt(0)" ::: "memory");
    const int c = lane & 7;
#pragma unroll
    for (int j = 0; j < 4; ++j) { const int n = (lane >> 3) + 8 * j; const LAS float* s = scr + (8 * c) * 33 + n;
        v4u o; o.x = pk2(s[0 * 33], s[1 * 33]); o.y = pk2(s[2 * 33], s[3 * 33]); o.z = pk2(s[4 * 33], s[5 * 33]); o.w = pk2(s[6 * 33], s[7 * 33]);
        *(v4u*)(WT + (size_t)(n0 + n) * DM + k0 + 8 * c) = o; }
    asm volatile("s_waitcnt lgkmcnt(0)" ::: "memory");
}

__device__ __forceinline__ void p0_phase(LAS unsigned char* lds, const float* c, const float* w_ada, const float* b_ada, const float* w_in, const float* w_out,
                                         float* mod, bf16* win_t, bf16* wout_t, int tid, int wid, int lane) {
    LAS float* cs = (LAS float*)lds;
    for (int unit = blockIdx.x; unit < 96; unit += gridDim.x) {
        const int l = unit / 48, nb = unit % 48;
        __syncthreads();
        for (int i = tid; i < 32 * 1024; i += 512) { const float cv = c[i]; cs[i] = siluf_(cv); }
        __syncthreads();
        const int n = nb * 64 + lane, kbase = wid * 128;
        const float* wp = w_ada + (size_t)l * 1024 * 3072 + (size_t)kbase * 3072 + n;
        float acc[32];
#pragma unroll
        for (int b = 0; b < 32; ++b) acc[b] = 0.f;
#pragma unroll 2
        for (int k = 0; k < 128; k += 4) {
            const float w0 = wp[(size_t)k * 3072], w1 = wp[(size_t)(k + 1) * 3072], w2 = wp[(size_t)(k + 2) * 3072], w3 = wp[(size_t)(k + 3) * 3072];
#pragma unroll
            for (int b = 0; b < 32; ++b) { const f32x4 cv = *(const LAS f32x4*)(cs + b * 1024 + kbase + k); acc[b] += cv[0] * w0 + cv[1] * w1 + cv[2] * w2 + cv[3] * w3; }
        }
        __syncthreads();
        LAS float* part = (LAS float*)lds;
#pragma unroll
        for (int b = 0; b < 32; ++b) part[(wid * 32 + b) * 64 + lane] = acc[b];
        __syncthreads();
        {
            const int nn = tid & 63, bg = tid >> 6;
#pragma unroll
            for (int bb = 0; bb < 4; ++bb) { const int b = bg * 4 + bb; float s = 0.f;
#pragma unroll
                for (int w = 0; w < 8; ++w) s += part[(w * 32 + b) * 64 + nn];
                mod[((size_t)l * 32 + b) * 3072 + nb * 64 + nn] = s + b_ada[l * 3072 + nb * 64 + nn]; }
        }
    }
    __syncthreads();
    LAS float* scr = (LAS float*)(lds + wid * 16384);
    int gw = blockIdx.x * 8 + wid, NGW = gridDim.x * 8;
    if (gridDim.x >= 192) { if (blockIdx.x < 96) return; gw -= 96 * 8; NGW -= 96 * 8; }
    constexpr int I_IN = 16 * (NPJ / 32), I_OUT = 16 * (DM / 32);
    for (int it = gw; it < 2 * (I_IN + I_OUT); it += NGW) {
        int r = it;
        if (r < 2 * I_IN) { const int l = r / I_IN; r -= l * I_IN; p0_transpose_item<true>(w_in + (size_t)l * DM * DIN, DIN, win_t + (size_t)l * WIN_ELEMS, scr, r, NPJ / 32, lane); }
        else { r -= 2 * I_IN; const int l = r / I_OUT; r -= l * I_OUT; p0_transpose_item<false>(w_out + (size_t)l * WOUT_ELEMS, DM, wout_t + (size_t)l * WOUT_ELEMS, scr, r, DM / 32, lane); }
    }
}

__device__ __forceinline__ void p1_phase(const float* xin, const float* g, const float* modl, bf16* H, int wid, int lane) {
    const int gw = blockIdx.x * 8 + wid, NGW = gridDim.x * 8;
    for (int base = gw * 32; base < MTOK; base += NGW * 32) {
        const int b = base >> 11;
        f32x4 gs[4], sh[4];
#pragma unroll
        for (int j = 0; j < 4; ++j) { const int k = 4 * lane + 256 * j;
            const f32x4 gg = *(const f32x4*)(g + k), sc = *(const f32x4*)(modl + (size_t)b * 3072 + 1024 + k);
            gs[j] = gg * (sc + 1.0f); sh[j] = *(const f32x4*)(modl + (size_t)b * 3072 + k); }
        for (int r = 0; r < 32; ++r) {
            const float* xr = xin + (size_t)(base + r) * DM + 4 * lane;
            f32x4 v[4]; float s = 0.f;
#pragma unroll
            for (int j = 0; j < 4; ++j) { v[j] = *(const f32x4*)(xr + 256 * j); s += (v[j][0] * v[j][0] + v[j][1] * v[j][1]) + (v[j][2] * v[j][2] + v[j][3] * v[j][3]); }
            const float rs = __builtin_amdgcn_rsqf(wave_sum(s) * (1.0f / DM) + EPSN);
            bf16* orow = H + (size_t)(base + r) * DM + 4 * lane;
#pragma unroll
            for (int j = 0; j < 4; ++j) { const f32x4 o = v[j] * rs * gs[j] + sh[j]; v2u w; w.x = pk2(o[0], o[1]); w.y = pk2(o[2], o[3]); *(v2u*)(orow + 256 * j) = w; }
        }
    }
}

struct AtPre { v4u k[2], v[2], q[2]; };
__device__ __forceinline__ void attn_unit(LAS unsigned char* lds, const bf16* P, bf16* Y, const float* gq, const float* gk, int b, int h, int qb, int tid, int wid, int lane,
                                          const bool have, AtPre& pf, const bool nvalid, const int nb, const int nh, const int nqb) {
    LAS bf16* Ks = (LAS bf16*)lds;
    LAS bf16* Vt = (LAS bf16*)(lds + 18432);
    volatile LAS int* flags = (volatile LAS int*)(lds + 35840);
    const int tq = lane & 15, quad = lane >> 4;
    const size_t row0 = (size_t)b * SEQ;
    const int t0 = qb * 128, t = t0 + 16 * wid + tq;
    const int sr = tid >> 3, dc = tid & 7, srv = tid & 127, dcv = tid >> 7;
    const bf16* kbase = P + (row0 + sr) * NPJ + PSK + h * 64 + 8 * dc;
    const bf16* vbase = P + (row0 + srv) * NPJ + PSV + h * 64 + 8 * dcv;
    v4u kwn[2], vwn[2], q0, q1;
    if (have) { kwn[0] = pf.k[0]; kwn[1] = pf.k[1]; vwn[0] = pf.v[0]; vwn[1] = pf.v[1]; q0 = pf.q[0]; q1 = pf.q[1]; }
    else {
        const size_t adv = (size_t)(128 * qb) * NPJ;
        kwn[0] = *(const v4u*)(kbase + adv); kwn[1] = *(const v4u*)(kbase + adv + (size_t)64 * NPJ);
        vwn[0] = *(const v4u*)(vbase + adv); vwn[1] = *(const v4u*)(vbase + adv + 32);
        const bf16* qp = P + (row0 + t) * NPJ + PSQ + h * 64;
        q0 = *(const v4u*)(qp + 8 * quad); q1 = *(const v4u*)(qp + 32 + 8 * quad);
    }
    bf16x8 Bq0, Bq1;
    {
        float qf[16];
#pragma unroll
        for (int i = 0; i < 4; ++i) { qf[2 * i] = blo(q0[i]); qf[2 * i + 1] = bhi(q0[i]); qf[8 + 2 * i] = blo(q1[i]); qf[9 + 2 * i] = bhi(q1[i]); }
        float ss = 0.f;
#pragma unroll
        for (int i = 0; i < 16; ++i) ss += qf[i] * qf[i];
        ss += __shfl_xor(ss, 16); ss += __shfl_xor(ss, 32);
        const float rs = __builtin_amdgcn_rsqf(ss * (1.0f / 64.0f) + EPSN) * (0.125f * LOG2E);
        const f32x4 g0 = *(const f32x4*)(gq + 8 * quad), g1 = *(const f32x4*)(gq + 8 * quad + 4), g2 = *(const f32x4*)(gq + 32 + 8 * quad), g3 = *(const f32x4*)(gq + 36 + 8 * quad);
#pragma unroll
        for (int i = 0; i < 4; ++i) { qf[i] *= rs * g0[i]; qf[4 + i] *= rs * g1[i]; qf[8 + i] *= rs * g2[i]; qf[12 + i] *= rs * g3[i]; }
        Bq0 = mk8(pk2(qf[0], qf[1]), pk2(qf[2], qf[3]), pk2(qf[4], qf[5]), pk2(qf[6], qf[7]));
        Bq1 = mk8(pk2(qf[8], qf[9]), pk2(qf[10], qf[11]), pk2(qf[12], qf[13]), pk2(qf[14], qf[15]));
    }
    v2u zwp[4];
    {
        const bf16* zp = P + (row0 + t) * NPJ + PSZ + h * 64 + 4 * quad;
#pragma unroll
        for (int dt = 0; dt < 4; ++dt) zwp[dt] = *(const v2u*)(zp + 16 * dt);
    }
    f32x4 O[4];
#pragma unroll
    for (int i = 0; i < 4; ++i) O[i] = (f32x4){0.f, 0.f, 0.f, 0.f};
    float R = 1.0f;
    bool wdone = false;
    if (tid < 3) flags[tid] = 0;
    const int tg = 8 * qb + wid;
    const f32x4 gk0 = *(const f32x4*)(gk + 8 * dc), gk1 = *(const f32x4*)(gk + 8 * dc + 4);
    int it = 0;
    for (int kt = qb; kt >= 0; --kt, ++it) {
        {
            v4u kw[2], vw[2];
            kw[0] = kwn[0]; kw[1] = kwn[1]; vw[0] = vwn[0]; vw[1] = vwn[1];
            if (kt > 0) {
                const size_t adv = (size_t)(128 * (kt - 1)) * NPJ;
                kwn[0] = *(const v4u*)(kbase + adv); kwn[1] = *(const v4u*)(kbase + adv + (size_t)64 * NPJ);
                vwn[0] = *(const v4u*)(vbase + adv); vwn[1] = *(const v4u*)(vbase + adv + 32);
            }
#pragma unroll
            for (int hf = 0; hf < 2; ++hf) {
                float kf[8];
#pragma unroll
                for (int i = 0; i < 4; ++i) { kf[2 * i] = blo(kw[hf][i]); kf[2 * i + 1] = bhi(kw[hf][i]); }
                float ss = 0.f;
#pragma unroll
                for (int i = 0; i < 8; ++i) ss += kf[i] * kf[i];
                ss += __shfl_xor(ss, 1); ss += __shfl_xor(ss, 2); ss += __shfl_xor(ss, 4);
                const float rs = __builtin_amdgcn_rsqf(ss * (1.0f / 64.0f) + EPSN);
#pragma unroll
                for (int i = 0; i < 4; ++i) { kf[i] *= rs * gk0[i]; kf[4 + i] *= rs * gk1[i]; }
                v4u o; o.x = pk2(kf[0], kf[1]); o.y = pk2(kf[2], kf[3]); o.z = pk2(kf[4], kf[5]); o.w = pk2(kf[6], kf[7]);
                *(LAS v4u*)(Ks + (sr + 64 * hf) * 72 + 8 * dc) = o;
#pragma unroll
                for (int i = 0; i < 4; ++i) { Vt[(8 * (dcv + 4 * hf) + 2 * i) * 136 + srv] = (bf16)(vw[hf][i] & 0xffffu); Vt[(8 * (dcv + 4 * hf) + 2 * i + 1) * 136 + srv] = (bf16)(vw[hf][i] >> 16); }
            }
        }
        if (tid == 0) flags[(it + 1) % 3] = 0;
        LBAR();
        if (!wdone) {
#pragma unroll
            for (int p = 3; p >= 0; --p) {
                if (8 * kt + 2 * p <= tg && !wdone) {
                    float av[2][4];
#pragma unroll
                    for (int u = 1; u >= 0; --u) {
                        const int st = 2 * p + u, sg = 8 * kt + st;
                        if (sg > tg) {
#pragma unroll
                            for (int j = 0; j < 4; ++j) av[u][j] = 0.f;
                        } else {
                            const bf16x8 a0 = *(const LAS bf16x8*)(Ks + (16 * st + tq) * 72 + 8 * quad), a1 = *(const LAS bf16x8*)(Ks + (16 * st + tq) * 72 + 32 + 8 * quad);
                            f32x4 z = (f32x4){0.f, 0.f, 0.f, 0.f};
                            z = mfma16(a0, Bq0, z); z = mfma16(a1, Bq1, z);
                            float r[4], be[4];
#pragma unroll
                            for (int j = 0; j < 4; ++j) { const float e = fexp2(fminf(z[j], 80.f)); const float rr = frcp(1.0f + e); r[j] = rr; be[j] = e * rr; }
                            if (sg == tg) {
                                int tql = tq; asm volatile("" : "+v"(tql));
#pragma unroll
                                for (int j = 0; j < 4; ++j) if (4 * quad + j >= tql) { r[j] = 1.0f; be[j] = 0.f; }
                            }
                            const float x2 = r[3], x1 = x2 * r[2], x0 = x1 * r[1], T = x0 * r[0];
                            const float A_ = __shfl_xor(T, 16), Bp = T * A_, Cc = __shfl_xor(Bp, 32);
                            const float Xq = quad == 3 ? 1.0f : (quad == 2 ? A_ : (quad == 1 ? Cc : A_ * Cc));
                            const float Yv = Xq * R;
                            av[u][3] = be[3] * Yv; av[u][2] = be[2] * (x2 * Yv); av[u][1] = be[1] * (x1 * Yv); av[u][0] = be[0] * (x0 * Yv);
                            R *= Bp * Cc;
                        }
                    }
                    const bf16x8 Bf = mk8(pk2(av[0][0], av[0][1]), pk2(av[0][2], av[0][3]), pk2(av[1][0], av[1][1]), pk2(av[1][2], av[1][3]));
#pragma unroll
                    for (int dt = 0; dt < 4; ++dt) {
                        const v2u lo = *(const LAS v2u*)(Vt + (16 * dt + tq) * 136 + 32 * p + 4 * quad), hi = *(const LAS v2u*)(Vt + (16 * dt + tq) * 136 + 32 * p + 16 + 4 * quad);
                        O[dt] = mfma16(mk8(lo.x, lo.y, hi.x, hi.y), Bf, O[dt]);
                    }
                    if (__ballot(R >= 1e-20f) == 0ull) wdone = true;
                }
            }
            if (!wdone && lane == 0) flags[it % 3] = 1;
        }
        if (it == 0 && nvalid) {
            const size_t nrow0 = (size_t)nb * SEQ, nadv = (size_t)(128 * nqb) * NPJ;
            const bf16* nk = P + (nrow0 + sr) * NPJ + PSK + nh * 64 + 8 * dc + nadv;
            const bf16* nv = P + (nrow0 + srv) * NPJ + PSV + nh * 64 + 8 * dcv + nadv;
            pf.k[0] = *(const v4u*)nk; pf.k[1] = *(const v4u*)(nk + (size_t)64 * NPJ);
            pf.v[0] = *(const v4u*)nv; pf.v[1] = *(const v4u*)(nv + 32);
            const bf16* nq = P + (nrow0 + 128 * nqb + 16 * wid + tq) * NPJ + PSQ + nh * 64;
            pf.q[0] = *(const v4u*)(nq + 8 * quad); pf.q[1] = *(const v4u*)(nq + 32 + 8 * quad);
        }
        LBAR();
        if (flags[it % 3] == 0) break;
    }
    {
        bf16* yp = Y + (row0 + t) * DM + 640 + h * 64 + 4 * quad;
#pragma unroll
        for (int dt = 0; dt < 4; ++dt) {
            const v2u zw = zwp[dt];
            v2u w; w.x = pk2(O[dt][0] * siluf_(blo(zw.x)), O[dt][1] * siluf_(bhi(zw.x))); w.y = pk2(O[dt][2] * siluf_(blo(zw.y)), O[dt][3] * siluf_(bhi(zw.y)));
            *(v2u*)(yp + 16 * dt) = w;
        }
    }
}

__device__ __forceinline__ void gmlp_unit(LAS unsigned char* lds, const bf16* P, bf16* Y, const float* wsl, const float* bsl, const float* gvl, int b, int cq, int g, int tid, int wid, int lane) {
    LAS bf16* Ws = (LAS bf16*)lds;
    const int tq = lane & 15, quad = lane >> 4;
    {
        int tt = tid >> 2; asm volatile("" : "+v"(tt)); const int sc = (tid & 3) * 32;
        const float* src = wsl + ((size_t)(g * 128 + tt)) * 128 + sc;
#pragma unroll
        for (int q2 = 0; q2 < 4; ++q2) {
            f32x4 f0 = *(const f32x4*)(src + 8 * q2), f1 = *(const f32x4*)(src + 8 * q2 + 4);
#pragma unroll
            for (int i = 0; i < 4; ++i) { if (sc + 8 * q2 + i > tt) f0[i] = 0.f; if (sc + 8 * q2 + 4 + i > tt) f1[i] = 0.f; }
            v4u o; o.x = pk2(f0[0], f0[1]); o.y = pk2(f0[2], f0[3]); o.z = pk2(f1[0], f1[1]); o.w = pk2(f1[2], f1[3]);
            *(LAS v4u*)(Ws + tt * 136 + sc + 8 * q2) = o;
        }
    }
    const int s = tid >> 2, dq = (tid & 3) * 16, tt = 16 * wid + tq;
    const size_t tokb = (size_t)b * SEQ + 512 * cq;
    const bf16* vp = P + (tokb + s) * NPJ + PV + g * 64 + dq;
    const bf16* up = P + (tokb + tt) * NPJ + PU + g * 64 + 4 * quad;
    bf16* yp = Y + (tokb + tt) * DM + g * 64 + 4 * quad;
    const float bs = bsl[g * 128 + tt];
    float gvr[16];
#pragma unroll
    for (int i = 0; i < 4; ++i) { const f32x4 t4 = *(const f32x4*)(gvl + g * 64 + dq + 4 * i); gvr[4 * i] = t4[0]; gvr[4 * i + 1] = t4[1]; gvr[4 * i + 2] = t4[2]; gvr[4 * i + 3] = t4[3]; }
    v4u nv0 = *(const v4u*)vp, nv1 = *(const v4u*)(vp + 8);
    v2u nuw[4], nzw[4];
#pragma unroll
    for (int dt = 0; dt < 4; ++dt) { nuw[dt] = *(const v2u*)(up + 16 * dt); nzw[dt] = *(const v2u*)(up + (PZ - PU) + 16 * dt); }
#pragma unroll 1
    for (int c4 = 0; c4 < 4; ++c4) {
        LAS bf16* Vn = (LAS bf16*)(lds + 34816 + (c4 & 1) * 17408);
        const v4u v0 = nv0, v1 = nv1;
        v2u uw[4], zw[4];
#pragma unroll
        for (int dt = 0; dt < 4; ++dt) { uw[dt] = nuw[dt]; zw[dt] = nzw[dt]; }
        if (c4 < 3) {
            const size_t adv = (size_t)(128 * (c4 + 1)) * NPJ;
            nv0 = *(const v4u*)(vp + adv); nv1 = *(const v4u*)(vp + adv + 8);
#pragma unroll
            for (int dt = 0; dt < 4; ++dt) { nuw[dt] = *(const v2u*)(up + adv + 16 * dt); nzw[dt] = *(const v2u*)(up + adv + (PZ - PU) + 16 * dt); }
        }
        {
            float vf[16];
#pragma unroll
            for (int i = 0; i < 4; ++i) { vf[2 * i] = geluf_(blo(v0[i])); vf[2 * i + 1] = geluf_(bhi(v0[i])); vf[8 + 2 * i] = geluf_(blo(v1[i])); vf[9 + 2 * i] = geluf_(bhi(v1[i])); }
            float ss = 0.f;
#pragma unroll
            for (int i = 0; i < 16; ++i) ss += vf[i] * vf[i];
            ss += __shfl_xor(ss, 1); ss += __shfl_xor(ss, 2);
            const float rs = __builtin_amdgcn_rsqf(ss * (1.0f / 64.0f) + EPSN);
#pragma unroll
            for (int i = 0; i < 16; ++i) { const float o = vf[i] * rs * gvr[i]; Vn[(dq + i) * 136 + s] = (bf16)(pk2(o, 0.f) & 0xffffu); }
        }
        LBAR();
        f32x4 acc[4];
#pragma unroll
        for (int i = 0; i < 4; ++i) acc[i] = (f32x4){0.f, 0.f, 0.f, 0.f};
#pragma unroll
        for (int kk = 0; kk < 4; ++kk) {
            if (kk <= (wid >> 1)) {
                const bf16x8 Bw = *(const LAS bf16x8*)(Ws + tt * 136 + 32 * kk + 8 * quad);
#pragma unroll
                for (int dt = 0; dt < 4; ++dt) { const bf16x8 Av = *(const LAS bf16x8*)(Vn + (16 * dt + tq) * 136 + 32 * kk + 8 * quad); acc[dt] = mfma16(Av, Bw, acc[dt]); }
            }
        }
        bf16* ypc = yp + (size_t)(128 * c4) * DM;
#pragma unroll
        for (int dt = 0; dt < 4; ++dt) {
            const float y0 = geluf_(blo(uw[dt].x)) * (acc[dt][0] + bs) * siluf_(blo(zw[dt].x)), y1 = geluf_(bhi(uw[dt].x)) * (acc[dt][1] + bs) * siluf_(bhi(zw[dt].x));
            const float y2 = geluf_(blo(uw[dt].y)) * (acc[dt][2] + bs) * siluf_(blo(zw[dt].y)), y3 = geluf_(bhi(uw[dt].y)) * (acc[dt][3] + bs) * siluf_(bhi(zw[dt].y));
            v2u w; w.x = pk2(y0, y1); w.y = pk2(y2, y3);
            *(v2u*)(ypc + 16 * dt) = w;
        }
    }
}

constexpr int ML_QS = 0, ML_KS = 26624, ML_KTS = 53248, ML_VTS = 79360, ML_CB = 109824, ML_GA = 133120, ML_GSTRIDE = 2688, ML_CW = 138496;
#define ML_ISSUE_LOADS(cc, TT)                                                                                                           \
    do {                                                                                                                                    \
        _Pragma("unroll") for (int itx = 0; itx < 3; ++itx) { const int idx = (TT) + 512 * itx, tk = idx / 12, dcx = idx - 12 * tk;         \
            const bf16* xp = P + (row0 + 128 * (cc) + tk) * NPJ + PMQ + h * 96 + 8 * dcx;                                                   \
            rq[itx] = *(const v4u*)xp; rk[itx] = *(const v4u*)(xp + (PMK - PMQ)); }                                                         \
        _Pragma("unroll") for (int itx = 0; itx < 3; ++itx) { const int idx = (TT) + 512 * itx, tk = idx & 127, dcx = idx >> 7;             \
            vv[itx] = *(const v4u*)(P + (row0 + 128 * (cc) + tk) * NPJ + PMV + h * 96 + 8 * dcx); }                                         \
        if ((TT) < 144) {                                                                                                                   \
            const int fi = (TT) / 24, rem = (TT) - 24 * fi, qk = rem / 12, dcx = rem - 12 * qk, jj = fi % 3, lr = (fi >= 3 ? 64 : 0) + jj;  \
            const int pp = 128 * (cc) + lr;                                                                                                 \
            const size_t colp = (size_t)(qk ? PMK : PMQ) + h * 96 + 8 * dcx;                                                                \
            const bf16* hb = HB + ((size_t)((row0 + pp) / 64) - 1) * 3 * 768 + qk * 384 + h * 96 + 8 * dcx;                                 \
            _Pragma("unroll") for (int d = 0; d < 4; ++d) {                                                                                 \
                v4u val = (v4u){0u, 0u, 0u, 0u};                                                                                            \
                if (pp - d >= 0) { if (d <= jj) val = *(const v4u*)(P + (row0 + pp - d) * NPJ + colp); else val = *(const v4u*)(hb + (size_t)(3 + jj - d) * 768); } \
                fx[3 - d] = val;                                                                                                            \
            }                                                                                                                               \
        }                                                                                                                                   \
    } while (0)
#define ML_GATES(cc, LN)                                                                                                                   \
    do {                                                                                                                                    \
        LAS float* GBw = (LAS float*)(lds + ML_GA + ((cc) & 1) * ML_GSTRIDE);                                                               \
        const int s0 = 2 * (LN);                                                                                                            \
        const float i0 = gi0 + bih, f0 = gf0 + bfh, i1 = gi1 + bih, f1 = gf1 + bfh;                                                         \
        if ((cc) < 15) { const float* gp = gate + (row0 + 128 * ((cc) + 1) + s0) * 8; gi0 = gp[h]; gf0 = gp[4 + h]; gi1 = gp[8 + h]; gf1 = gp[12 + h]; } \
        const float lf0 = logsigf_(f0), lf1 = logsigf_(f1);                                                                                 \
        const float p = lf0 + lf1; float inc = p;                                                                                           \
        _Pragma("unroll") for (int off = 1; off < 64; off <<= 1) { const float v = __shfl_up(inc, off); if ((LN) >= off) inc += v; }        \
        const float bc0 = (inc - p) + lf0, bc1 = inc;                                                                                       \
        const float a0 = i0 - bc0, a1 = i1 - bc1;                                                                                           \
        float incm = fmaxf(a0, a1);                                                                                                         \
        _Pragma("unroll") for (int off = 1; off < 64; off <<= 1) { const float v = __shfl_up(incm, off); if ((LN) >= off) incm = fmaxf(incm, v); } \
        float excm = __shfl_up(incm, 1); if ((LN) == 0) excm = -INFINITY;                                                                   \
        const float M0 = fmaxf(m_prev, fmaxf(excm, a0)), M1 = fmaxf(m_prev, incm);                                                          \
        const float M127 = __shfl(M1, 63), btot = __shfl(bc1, 63);                                                                          \
        GBw[s0] = a0 * LOG2E; GBw[s0 + 1] = a1 * LOG2E; GBw[128 + s0] = M0 * LOG2E; GBw[129 + s0] = M1 * LOG2E;                             \
        GBw[256 + s0] = fexp(m_prev - M0); GBw[257 + s0] = fexp(m_prev - M1);                                                               \
        GBw[384 + s0] = fexp(-(bc0 + M0)); GBw[385 + s0] = fexp(-(bc1 + M1));                                                               \
        GBw[512 + s0] = fexp(a0 - M127); GBw[513 + s0] = fexp(a1 - M127);                                                                   \
        if ((LN) == 0) GBw[640] = fexp(m_prev - M127);                                                                                      \
        m_prev = btot + M127;                                                                                                               \
    } while (0)
__device__ __forceinline__ void mlstm_unit(LAS unsigned char* lds, const bf16* P, const bf16* HB, const float* gate, bf16* Y, const float* convw, const float* convb, const float* bi, const float* bfv, const float* hn,
                                           int b, int h, int tid, int wid, int lane, const int mode = 0) {
    LAS bf16* QS = (LAS bf16*)(lds + ML_QS);
    LAS bf16* KS = (LAS bf16*)(lds + ML_KS);
    LAS bf16* KTS = (LAS bf16*)(lds + ML_KTS);
    LAS bf16* VTS = (LAS bf16*)(lds + ML_VTS);
    LAS bf16* CB = (LAS bf16*)(lds + ML_CB);
    const int tq = lane & 15, quad = lane >> 4;
    const size_t row0 = (size_t)b * SEQ;
    for (int i = tid; i < 112 * 104 / 2; i += 512) ((LAS unsigned*)CB)[i] = 0u;
    for (int i = tid; i < 16 * 136; i += 512) VTS[96 * 136 + i] = (i < 136) ? (bf16)0x3F80 : (bf16)0;
    LAS float* CW = (LAS float*)(lds + ML_CW);
    LAS float* HNL = (LAS float*)(lds + ML_CW + 3840);
    if (tid < 96) HNL[tid] = hn[h * 96 + tid];
    for (int i = tid; i < 960; i += 512) { const int qk = i / 480, r = i - 480 * qk, tap = r / 96, ch = r - 96 * tap; CW[i] = tap < 4 ? convw[tap * 768 + qk * 384 + h * 96 + ch] : convb[qk * 384 + h * 96 + ch]; }
    f32x4 Cm[6];
#pragma unroll
    for (int i = 0; i < 6; ++i) Cm[i] = (f32x4){0.f, 0.f, 0.f, 0.f};
    float m_prev = 0.f;
    const float bih = bi[h], bfh = bfv[h];
    __syncthreads();
    float gi0 = 0.f, gf0 = 0.f, gi1 = 0.f, gf1 = 0.f;
    if (wid == 0) { const float* gp = gate + (row0 + 2 * lane) * 8; gi0 = gp[h]; gf0 = gp[4 + h]; gi1 = gp[8 + h]; gf1 = gp[12 + h]; }
    if (wid == 0 && !(mode & 16)) ML_GATES(0, lane);
    v4u rq[3], rk[3], fx[4]; v4u vv[3];
#pragma unroll
    for (int d = 0; d < 4; ++d) fx[d] = (v4u){0u, 0u, 0u, 0u};
    ML_ISSUE_LOADS(0, tid);
    for (int c = 0; c < 16; ++c) {
        const size_t tok0 = row0 + 128 * c;
        int tidc = tid, lanec = lane; asm volatile("" : "+v"(tidc), "+v"(lanec));
        const int tq = lanec & 15, quad = lanec >> 4;
        LAS float* GA = (LAS float*)(lds + ML_GA + (c & 1) * ML_GSTRIDE); LAS float* GM = GA + 128; LAS float* GWI = GA + 256; LAS float* GFL = GA + 384; LAS float* GWS = GA + 512; LAS float* GSC = GA + 640;
#pragma unroll
        for (int itx = 0; itx < 3; ++itx) { const int idx = tidc + 512 * itx, tk = idx / 12, dcx = idx - 12 * tk;
            if ((tk & 63) >= 3) { *(LAS v4u*)(QS + tk * 104 + 8 * dcx) = rq[itx]; *(LAS v4u*)(KS + tk * 104 + 8 * dcx) = rk[itx]; } }
        if (tidc < 144) {
            const int fi = tidc / 24, rem = tidc - 24 * fi, qk = rem / 12, dcx = rem - 12 * qk, lr = (fi >= 3 ? 64 : 0) + fi % 3;
            const LAS float* cwp = CW + qk * 480 + 8 * dcx;
            const f32x4 cb0 = *(const LAS f32x4*)(cwp + 384), cb1 = *(const LAS f32x4*)(cwp + 388);
            f32x4 a0 = cb0, a1 = cb1;
#pragma unroll
            for (int tap = 0; tap < 4; ++tap) {
                const f32x4 w0 = *(const LAS f32x4*)(cwp + tap * 96), w1 = *(const LAS f32x4*)(cwp + tap * 96 + 4);
                const v4u xw = fx[tap];
                a0[0] = __builtin_fmaf(w0[0], blo(xw.x), a0[0]); a0[1] = __builtin_fmaf(w0[1], bhi(xw.x), a0[1]); a0[2] = __builtin_fmaf(w0[2], blo(xw.y), a0[2]); a0[3] = __builtin_fmaf(w0[3], bhi(xw.y), a0[3]);
                a1[0] = __builtin_fmaf(w1[0], blo(xw.z), a1[0]); a1[1] = __builtin_fmaf(w1[1], bhi(xw.z), a1[1]); a1[2] = __builtin_fmaf(w1[2], blo(xw.w), a1[2]); a1[3] = __builtin_fmaf(w1[3], bhi(xw.w), a1[3]);
            }
            const float sc = qk ? 0.10206207261596575f : 1.0f;
            v4u o;
            o.x = pk2(siluf_(a0[0]) * sc, siluf_(a0[1]) * sc); o.y = pk2(siluf_(a0[2]) * sc, siluf_(a0[3]) * sc);
            o.z = pk2(siluf_(a1[0]) * sc, siluf_(a1[1]) * sc); o.w = pk2(siluf_(a1[2]) * sc, siluf_(a1[3]) * sc);
            *(LAS v4u*)((qk ? KS : QS) + lr * 104 + 8 * dcx) = o;
        }
#pragma unroll
        for (int itx = 0; itx < 3; ++itx) {
            if (mode & 2) { if (vv[itx][0] == 0x12345678u) VTS[tidc] = 1; continue; }
            const int idx = tidc + 512 * itx, tk = idx & 127, dcx = idx >> 7;
#pragma unroll
            for (int i = 0; i < 4; ++i) { VTS[(8 * dcx + 2 * i) * 136 + tk] = (bf16)(vv[itx][i] & 0xffffu); VTS[(8 * dcx + 2 * i + 1) * 136 + tk] = (bf16)(vv[itx][i] >> 16); }
        }
        LBAR();
        v2u owp[6], zwp[6];
        {
            const bf16* op = P + (tok0 + 16 * wid + tq) * NPJ + PMO + h * 96 + 4 * quad;
#pragma unroll
            for (int et = 0; et < 6; ++et) { owp[et] = *(const v2u*)(op + 16 * et); zwp[et] = *(const v2u*)(op + (PMZ - PMO) + 16 * et); }
        }
        if (c < 15) ML_ISSUE_LOADS(c + 1, tidc);
#pragma unroll
        for (int itx = 0; itx < 3; ++itx) {
            if (mode & 2) break;
            const int idx = tidc + 512 * itx, s = idx & 127, dcx = idx >> 7;
            const v4u kw = *(const LAS v4u*)(KS + s * 104 + 8 * dcx);
            const float wv = GWS[s];
#pragma unroll
            for (int i = 0; i < 4; ++i) { const unsigned pw = pk2(blo(kw[i]) * wv, bhi(kw[i]) * wv); KTS[(8 * dcx + 2 * i) * 136 + s] = (bf16)(pw & 0xffffu); KTS[(8 * dcx + 2 * i + 1) * 136 + s] = (bf16)(pw >> 16); }
        }
        if (!(mode & 4)) {
            const int tt = 16 * wid + tq;
            bf16x8 Bq[3];
#pragma unroll
            for (int kk = 0; kk < 3; ++kk) Bq[kk] = *(const LAS bf16x8*)(QS + tt * 104 + 32 * kk + 8 * quad);
            f32x4 acc[7];
            const float wi = GWI[tt];
#pragma unroll
            for (int et = 0; et < 7; ++et) {
                f32x4 a = (f32x4){0.f, 0.f, 0.f, 0.f};
#pragma unroll
                for (int kk = 0; kk < 3; ++kk) a = mfma16(*(const LAS bf16x8*)(CB + (16 * et + tq) * 104 + 32 * kk + 8 * quad), Bq[kk], a);
                acc[et] = a * wi;
            }
            const float Mt2 = GM[tt];
            int ttl = tt; asm volatile("" : "+v"(ttl));
#pragma unroll
            for (int p = 0; p < 4; ++p) {
                if (2 * p <= wid) {
                    float sv[2][4];
#pragma unroll
                    for (int u = 0; u < 2; ++u) {
                        const int st = 2 * p + u;
                        if (st > wid) {
#pragma unroll
                            for (int j = 0; j < 4; ++j) sv[u][j] = 0.f;
                        } else {
                            f32x4 z = (f32x4){0.f, 0.f, 0.f, 0.f};
#pragma unroll
                            for (int kk = 0; kk < 3; ++kk) z = mfma16(*(const LAS bf16x8*)(KS + (16 * st + tq) * 104 + 32 * kk + 8 * quad), Bq[kk], z);
                            const f32x4 a4 = *(const LAS f32x4*)(GA + 16 * st + 4 * quad);
#pragma unroll
                            for (int j = 0; j < 4; ++j) { float val = z[j] * fexp2(a4[j] - Mt2); if (16 * st + 4 * quad + j > ttl) val = 0.f; sv[u][j] = val; }
                        }
                    }
                    const bf16x8 Bf = mk8(pk2(sv[0][0], sv[0][1]), pk2(sv[0][2], sv[0][3]), pk2(sv[1][0], sv[1][1]), pk2(sv[1][2], sv[1][3]));
#pragma unroll
                    for (int et = 0; et < 7; ++et) {
                        const v2u lo = *(const LAS v2u*)(VTS + (16 * et + tq) * 136 + 32 * p + 4 * quad), hi = *(const LAS v2u*)(VTS + (16 * et + tq) * 136 + 32 * p + 16 + 4 * quad);
                        acc[et] = mfma16(mk8(lo.x, lo.y, hi.x, hi.y), Bf, acc[et]);
                    }
                }
            }
            const float den = __shfl(acc[6][0], tq);
            const float inv = 1.0f / fmaxf(fabsf(den), GFL[tt]);
            float ss = 0.f;
#pragma unroll
            for (int et = 0; et < 6; ++et) { acc[et] = acc[et] * inv; ss += (acc[et][0] * acc[et][0] + acc[et][1] * acc[et][1]) + (acc[et][2] * acc[et][2] + acc[et][3] * acc[et][3]); }
            ss += __shfl_xor(ss, 16); ss += __shfl_xor(ss, 32);
            const float rs = __builtin_amdgcn_rsqf(ss * (1.0f / 96.0f) + EPSN);
            const size_t row = tok0 + tt;
            bf16* yp = Y + row * DM + 256 + h * 96 + 4 * quad;
#pragma unroll
            for (int et = 0; et < 6; ++et) {
                const v2u ow = owp[et], zw = zwp[et];
                const f32x4 hv = *(const LAS f32x4*)(HNL + 16 * et + 4 * quad);
                const float y0 = acc[et][0] * rs * hv[0] * blo(ow.x) * blo(zw.x), y1 = acc[et][1] * rs * hv[1] * bhi(ow.x) * bhi(zw.x);
                const float y2 = acc[et][2] * rs * hv[2] * blo(ow.y) * blo(zw.y), y3 = acc[et][3] * rs * hv[3] * bhi(ow.y) * bhi(zw.y);
                v2u w; w.x = pk2(y0, y1); w.y = pk2(y2, y3);
                *(v2u*)(yp + 16 * et) = w;
            }
        }
        if (wid == 0 && c < 15 && !(mode & 16)) ML_GATES(c + 1, lanec);
        LBAR();
        if (!(mode & 8)) {
            const float decay = GSC[0];
#pragma unroll
            for (int i = 0; i < 6; ++i) {
                const int idx = wid + 8 * i;
                if (idx < 42) {
                    const int et = idx / 6, dtl = idx - 6 * et;
                    f32x4 tmp = (f32x4){0.f, 0.f, 0.f, 0.f};
#pragma unroll
                    for (int kk = 0; kk < 4; ++kk)
                        tmp = mfma16(*(const LAS bf16x8*)(VTS + (16 * et + tq) * 136 + 32 * kk + 8 * quad), *(const LAS bf16x8*)(KTS + (16 * dtl + tq) * 136 + 32 * kk + 8 * quad), tmp);
                    Cm[i] = Cm[i] * decay + tmp;
#pragma unroll
                    for (int j = 0; j < 4; ++j) CB[(16 * et + 4 * quad + j) * 104 + 16 * dtl + tq] = (bf16)(pk2(Cm[i][j], 0.f) & 0xffffu);
                }
            }
        }
        LBAR();
    }
}

struct LayerP {
    const float *gv, *gws, *gbs, *convw, *convb, *bi, *bfv, *hn, *gq, *gk; const bf16* halo;
};
__device__ __forceinline__ int p3_fetch_(volatile LAS int* s_unit, unsigned* counter, int tid, int& pre, int& pre2, int& nxt) {
    LBAR();
    if (tid == 0) { s_unit[0] = pre; s_unit[1] = pre2; }
    LBAR();
    const int u = __builtin_amdgcn_readfirstlane(s_unit[0]);
    nxt = __builtin_amdgcn_readfirstlane(s_unit[1]);
    if (tid == 0) { pre = pre2; pre2 = (int)atomicAdd(counter, 1u); }
    return u;
}
__device__ __forceinline__ void p3_phase(LAS unsigned char* lds, const bf16* P, const float* gate, bf16* Y, const LayerP& lp, unsigned* counter, int tid, int wid, int lane, const int ubase = 0, const int uend = N_UNITS, const int mode = 0) {
    volatile LAS int* s_unit = (volatile LAS int*)(lds + LDS_BYTES - 64);
#define p3_fetch(a_, b_, c_) (ubase + p3_fetch_(a_, b_, c_, pre, pre2, nxt_))
    int pre = 0, pre2 = 0, nxt_ = 0; if (tid == 0) { pre = (int)atomicAdd(counter, 1u); pre2 = (int)atomicAdd(counter, 1u); }
    int u = p3_fetch(s_unit, counter, tid);
#ifndef SKIP_ML
    while (u < N_ML && u < uend) { mlstm_unit(lds, P, lp.halo, gate, Y, lp.convw, lp.convb, lp.bi, lp.bfv, lp.hn, u >> 2, u & 3, tid, wid, lane, mode); u = p3_fetch(s_unit, counter, tid); }
#endif
#ifndef SKIP_AT
    {
        AtPre pf; bool have = false;
#pragma unroll
        for (int i = 0; i < 2; ++i) { pf.k[i] = (v4u){0u, 0u, 0u, 0u}; pf.v[i] = (v4u){0u, 0u, 0u, 0u}; pf.q[i] = (v4u){0u, 0u, 0u, 0u}; }
        while (u < N_ML + N_AT && u < uend) {
            const int idx = u - N_ML, qb = 15 - idx / 192, rem = idx % 192;
            const int nu = ubase + nxt_; const bool nvalid = nu < N_ML + N_AT && nu < uend; const int nidx = nu - N_ML, nqb = 15 - nidx / 192, nrem = nidx % 192;
            attn_unit(lds, P, Y, lp.gq, lp.gk, rem / 6, rem % 6, qb, tid, wid, lane, have, pf, nvalid, nrem / 6, nrem % 6, nqb);
            have = nvalid;
            u = p3_fetch(s_unit, counter, tid);
        }
    }
#endif
#ifndef SKIP_GM
    while (u < uend) { const int idx = u - N_ML - N_AT; gmlp_unit(lds, P, Y, lp.gws, lp.gbs, lp.gv, idx >> 4, (idx >> 2) & 3, idx & 3, tid, wid, lane); u = p3_fetch(s_unit, counter, tid); }
#endif
#undef p3_fetch
}

__device__ __forceinline__ void fast_grid_barrier(unsigned* base, int seam, int tid) {
    asm volatile("s_waitcnt vmcnt(0)" ::: "memory");
    __syncthreads();
    if (tid == 0) {
        unsigned* cnt = base + seam * 128;
        unsigned* flg = cnt + 64;
        __builtin_amdgcn_fence(__ATOMIC_RELEASE, "agent");
        asm volatile("s_waitcnt vmcnt(0)" ::: "memory");
        const unsigned old = __hip_atomic_fetch_add(cnt, 1u, __ATOMIC_RELAXED, __HIP_MEMORY_SCOPE_AGENT);
        if (old == gridDim.x - 1) __hip_atomic_store(flg, 1u, __ATOMIC_RELAXED, __HIP_MEMORY_SCOPE_AGENT);
        else { unsigned sp = 0; while (__hip_atomic_load(flg, __ATOMIC_RELAXED, __HIP_MEMORY_SCOPE_AGENT) == 0u) { __builtin_amdgcn_s_sleep(2); if (++sp > (1u << 22)) break; } }
        __builtin_amdgcn_fence(__ATOMIC_ACQUIRE, "agent");
        asm volatile("s_waitcnt vmcnt(0)" ::: "memory");
    }
    __syncthreads();
}

#ifndef P3_WID
#define P3_WID wid
#endif
#ifndef DUP_MODE
#define DUP_MODE 0
#endif
struct Args { const float* in[17]; float* out; unsigned char* ws; int ph_lo, ph_hi; };
struct RowOrder {
    int c;
    __device__ __forceinline__ bool next(int i, pg8::Unit& u) const { if (i >= DM / 256) return false; u.pm = c; u.pn = i; return true; }
    __device__ __forceinline__ void a_ready(const pg8::Unit&) const {}
    __device__ __forceinline__ void done(const pg8::Unit&) const {}
};
typedef const __attribute__((address_space(4))) Args* KArgP;
template <int PH>
__device__ __forceinline__ void run_phase(LAS unsigned char* lds, int tid, int wid, int lane) {
#if defined(__HIP_DEVICE_COMPILE__)
    KArgP ap = (KArgP)__builtin_amdgcn_kernarg_segment_ptr(); asm volatile("" : "+s"(ap));
    const Args a = *ap;
#else
    const Args a{};
#endif
    unsigned char* ws = a.ws;
    float* mod = (float*)(ws + WS_MOD); float* gate = (float*)(ws + WS_GATE);
    bf16* win_t = (bf16*)(ws + WS_WIN); bf16* wout_t = (bf16*)(ws + WS_WOUT);
    bf16* H = (bf16*)(ws + WS_H); bf16* PJ = (bf16*)(ws + WS_PROJ);
    if constexpr (PH == 0) {
#ifndef SKIP_P0
        p0_phase(lds, a.in[1], a.in[3], a.in[4], a.in[5], a.in[16], mod, win_t, wout_t, tid, wid, lane);
#endif
    } else {
        constexpr int l = (PH - 1) >> 2, sub = (PH - 1) & 3;
        const float* xin = l == 0 ? a.in[0] : a.out;
        if constexpr (sub == 0) {
#ifndef SKIP_P1
            p1_phase(xin, a.in[2] + l * DM, mod + (size_t)l * 32 * 3072, H, wid, lane);
#endif
        } else if constexpr (sub == 1) {
#ifndef SKIP_G1
            pg8::Gemm g{H, win_t + (size_t)l * WIN_ELEMS, MTOK, NPJ, DM}; pg8::StaticOrder S; S.init(MTOK, NPJ, (int)gridDim.x, (int)blockIdx.x);
            EpiProj E{PJ, gate, a.in[9] + l * 4 * 768, a.in[10] + l * 768, (bf16*)(ws + WS_HALO)};
            pg8::gemm_phase<EpiProj, pg8::StaticOrder, true, true>(lds, g, S, E);
#if defined(DUP_P2)
            if (l == 0) { __syncthreads(); pg8::gemm_phase<EpiProj, pg8::StaticOrder, true, true>(lds, g, S, E); }
#endif
#endif
        } else if constexpr (sub == 2) {
            LayerP lp;
            lp.gv = a.in[6] + l * 256; lp.gws = a.in[7] + (size_t)l * 4 * 128 * 128; lp.gbs = a.in[8] + l * 512; lp.convw = a.in[9] + l * 4 * 768; lp.convb = a.in[10] + l * 768;
            lp.bi = a.in[11] + l * 4; lp.bfv = a.in[12] + l * 4; lp.hn = a.in[13] + l * 384; lp.gq = a.in[14] + l * 64; lp.gk = a.in[15] + l * 64; lp.halo = (const bf16*)(ws + WS_HALO);
            p3_phase(lds, PJ, gate, H, lp, (unsigned*)(ws + WS_CTL) + 64 * l, tid, P3_WID, lane);
#if defined(DUP_P3)
            if (l == 0) { __syncthreads(); p3_phase(lds, PJ, gate, (bf16*)(ws + 800 * MiB), lp, (unsigned*)(ws + WS_CTL) + 64 * (l + 2), tid, P3_WID, lane, DUP_LO, DUP_HI, DUP_MODE); }
#endif
        } else {
#ifndef SKIP_G2
            pg8::Gemm g{H, wout_t + (size_t)l * WOUT_ELEMS, MTOK, DM, DM};
            EpiOut E{xin, a.out, mod + (size_t)l * 32 * 3072 + 2048};
            if (l == 0 && gridDim.x == MTOK / 256) {
                RowOrder S{(int)blockIdx.x};
                pg8::gemm_phase<EpiOut, RowOrder, true, true>(lds, g, S, E);
                asm volatile("s_waitcnt vmcnt(0)" ::: "memory");
                __syncthreads();
                __builtin_amdgcn_fence(__ATOMIC_ACQUIRE, "agent");
                p1_phase(a.out, a.in[2] + DM, mod + (size_t)32 * 3072, H, wid, lane);
            } else {
                pg8::StaticOrder S; S.init(MTOK, DM, (int)gridDim.x, (int)blockIdx.x);
                pg8::gemm_phase<EpiOut, pg8::StaticOrder, true, true>(lds, g, S, E);
            }
#endif
        }
    }
}
__global__ void __launch_bounds__(512, 2) hybrid_fwd(Args a) {
    extern __shared__ __attribute__((aligned(16))) unsigned char lds_raw[];
    LAS unsigned char* lds = (LAS unsigned char*)lds_raw;
    const int tid = threadIdx.x, lane = tid & 63, wid = __builtin_amdgcn_readfirstlane(tid >> 6);
    const int lo = a.ph_lo, hi = a.ph_hi;
#define IN(k) (lo <= (k) && (k) < hi)
#ifdef DUP_SYNC
#define EXTRA_SYNC() do { cg::this_grid().sync(); cg::this_grid().sync(); } while (0)
#else
#define EXTRA_SYNC() do { } while (0)
#endif
#define SEAM(k) fast_grid_barrier((unsigned*)(a.ws + 1024), (k), tid)
#define PHASE(k) do { if (IN(k)) { run_phase<k>(lds, tid, wid, lane); if (IN((k) + 1)) { SEAM(k); EXTRA_SYNC(); } } } while (0)
    if (hi > NPHASE) cg::this_grid().sync();
    const bool fused45 = (gridDim.x == MTOK / 256) && IN(4) && IN(5);
    PHASE(0); PHASE(1); PHASE(2); PHASE(3);
    if (fused45) { run_phase<4>(lds, tid, wid, lane); if (IN(6)) SEAM(5); }
    else { PHASE(4); PHASE(5); }
    PHASE(6); PHASE(7); PHASE(8);
#undef PHASE
#undef IN
}

extern "C" void kernel_launch(void* const* d_in, const int* in_sizes, int n_in, void* d_out, int out_size, void* d_ws, size_t ws_size, hipStream_t stream) {
    static int grid = 0;
    if (grid == 0) {
        if (n_in != 17 || out_size != MTOK * DM || ws_size < WS_END) { fprintf(stderr, "kernel_launch: unexpected shapes (n_in %d out %d ws %zu)\n", n_in, out_size, ws_size); grid = -1; return; }
        int dev = 0, cus = 0, per_cu = 0;
        (void)hipGetDevice(&dev);
        (void)hipDeviceGetAttribute(&cus, hipDeviceAttributeMultiprocessorCount, dev);
        if (hipFuncSetAttribute((const void*)hybrid_fwd, hipFuncAttributeMaxDynamicSharedMemorySize, LDS_BYTES) != hipSuccess) { fprintf(stderr, "kernel_launch: hipFuncSetAttribute failed\n"); }
        if (hipOccupancyMaxActiveBlocksPerMultiprocessor(&per_cu, (const void*)hybrid_fwd, 512, LDS_BYTES) != hipSuccess || per_cu < 1) { fprintf(stderr, "kernel_launch: occupancy query gave %d\n", per_cu); per_cu = 1; }
        (void)hipGetLastError();
        if (cus <= 0) cus = 256;
        grid = cus * 1;
        (void)per_cu;
    }
    if (grid < 0) return;
    (void)hipMemsetAsync((char*)d_ws + WS_CTL, 0, 8192, stream);
    Args a{};
    for (int i = 0; i < 17; ++i) a.in[i] = (const float*)d_in[i];
    a.out = (float*)d_out; a.ws = (unsigned char*)d_ws;
#if ONE_LAUNCH
    a.ph_lo = 0; a.ph_hi = NPHASE;
    void* args[] = {&a};
    hipError_t e = hipLaunchCooperativeKernel((const void*)hybrid_fwd, dim3(grid), dim3(512), args, LDS_BYTES, stream);
    if (e != hipSuccess) fprintf(stderr, "cooperative launch failed: %s (grid %d)\n", hipGetErrorString(e), grid);
#else
    for (int ph = 0; ph < NPHASE; ++ph) {
        a.ph_lo = ph; a.ph_hi = ph + 1;
        hipLaunchKernelGGL(hybrid_fwd, dim3(grid), dim3(512), LDS_BYTES, stream, a);
    }
#endif
}
```
